# Optimizing an MI355X kernel written in HIP

```python
import jax, jax.numpy as jnp
from jax import lax
import numpy as np

D_MODEL = 1024
BATCH = 4
SEQ = 4096
DEPTH = 4
DEC_BATCH = 128
DEC_SEQ = 8
PAST_LEN = 8192
PAGE_SIZE = 128

N_HEADS = 16
N_KV_HEADS = 4
HEAD_DIM = D_MODEL // N_HEADS
GROUP = N_HEADS // N_KV_HEADS
WINDOW = 128
ATTN_BLOCK = WINDOW
D_ATTN = N_HEADS * HEAD_DIM
D_KV = N_KV_HEADS * HEAD_DIM
REC_HEADS = 8
REC_DK = 128
REC_DV = D_MODEL // REC_HEADS
D_REC_K = REC_HEADS * REC_DK
D_REC_V = REC_HEADS * REC_DV
REC_CHUNK = 64
D_FF = 4 * D_MODEL
N_MOD = 6
EPS = 1e-6
MASK_VALUE = -1e30
IN_SIZES = (D_ATTN, D_KV, D_KV, D_REC_K, D_REC_K, D_REC_V, D_REC_V, D_MODEL, D_MODEL)
IN_COLS = sum(IN_SIZES)

kernel_name = 'hybrid_swa_sink_alibi_hgrn2_adaln_step'


def rms_norm(x, g):
    xf = x.astype(jnp.float32)
    y = xf * lax.rsqrt(jnp.mean(jnp.square(xf), axis=-1, keepdims=True) + EPS)
    return (y * g.astype(jnp.float32)).astype(x.dtype)


def alibi_slopes():
    return 2.0 ** (-8.0 * jnp.arange(1, N_HEADS + 1, dtype=jnp.float32) / N_HEADS)


def sink_attention(q, k, v, qpos, kpos, sinks):
    s = jnp.einsum('bnqkgd,bnskd->bnkgqs', q, k).astype(jnp.float32) * HEAD_DIM ** -0.5
    dist = qpos[:, :, None] - kpos[:, None, :]
    valid = (dist >= 0) & (dist <= WINDOW) & (kpos[:, None, :] >= 0)
    slopes = alibi_slopes().reshape(N_KV_HEADS, GROUP)[None, None, :, :, None, None]
    s = s - slopes * dist.astype(jnp.float32)[None, :, None, None]
    s = jnp.where(valid[None, :, None, None], s, MASK_VALUE)
    sink = sinks.astype(jnp.float32).reshape(N_KV_HEADS, GROUP)[None, None, :, :, None, None]
    m = jnp.maximum(jnp.max(s, axis=-1, keepdims=True), sink)
    p = jnp.exp(s - m)
    p = p / (jnp.sum(p, axis=-1, keepdims=True) + jnp.exp(sink - m))
    return jnp.einsum('bnkgqs,bnskd->bnqkgd', p.astype(v.dtype), v)


def swa_prompt(q, k, v, sinks):
    B, L = q.shape[:2]
    nb = L // ATTN_BLOCK
    qb = q.reshape(B, nb, ATTN_BLOCK, N_KV_HEADS, GROUP, HEAD_DIM)

    def with_prev(t):
        t = t.reshape(B, nb, ATTN_BLOCK, N_KV_HEADS, HEAD_DIM)
        prev = jnp.concatenate([jnp.zeros_like(t[:, :1]), t[:, :-1]], axis=1)
        return jnp.concatenate([prev, t], axis=2)

    start = jnp.arange(nb) * ATTN_BLOCK
    qpos = start[:, None] + jnp.arange(ATTN_BLOCK)[None]
    kpos = start[:, None] - ATTN_BLOCK + jnp.arange(2 * ATTN_BLOCK)[None]
    o = sink_attention(qb, with_prev(k), with_prev(v), qpos, kpos, sinks)
    return o.reshape(B, L, D_ATTN)


def swa_sample(q, k, v, buf_k, buf_v, sinks):
    B, L = q.shape[:2]
    w = buf_k.shape[1]
    k_all = jnp.concatenate([buf_k, k.astype(buf_k.dtype)], axis=1)
    v_all = jnp.concatenate([buf_v, v.astype(buf_v.dtype)], axis=1)
    qpos = (PAST_LEN + jnp.arange(L))[None]
    kpos = (PAST_LEN - w + jnp.arange(w + L))[None]
    o = sink_attention(q.reshape(B, 1, L, N_KV_HEADS, GROUP, HEAD_DIM),
                       k_all[:, None], v_all[:, None], qpos, kpos, sinks)
    return o.reshape(B, L, D_ATTN), k_all[:, -w:], v_all[:, -w:]


def hgrn2_chunked(q, k, v, logf, s0):
    B, L, H, _ = q.shape
    C = min(REC_CHUNK, L)
    n = -(-L // C)
    pad = n * C - L

    def prep(t):
        t = jnp.pad(t, ((0, 0), (0, pad), (0, 0), (0, 0)))
        return jnp.moveaxis(t.reshape(B, n, C, H, t.shape[-1]), 1, 0)

    tri = jnp.tril(jnp.ones((C, C), dtype=bool))[None, :, :, None, None]

    def step(S, inp):
        qc, kc, vc, gc = inp
        b = jnp.cumsum(gc, axis=1)
        o_inter = jnp.einsum('bthk,bhkv->bthv', qc * jnp.exp(b), S)
        diff = b[:, :, None] - b[:, None, :]
        decay = jnp.where(tri, jnp.exp(jnp.where(tri, diff, 0.0)), 0.0)
        att = jnp.einsum('bthk,bshk,btshk->bhts', qc, kc, decay)
        o_intra = jnp.einsum('bhts,bshv->bthv', att, vc)
        b_last = b[:, -1]
        S = jnp.exp(b_last)[..., None] * S + jnp.einsum(
            'bshk,bshv->bhkv', kc * jnp.exp(b_last[:, None] - b), vc)
        return S, o_inter + o_intra

    S, o = lax.scan(step, s0, (prep(q), prep(k), prep(v), prep(logf)))
    o = jnp.moveaxis(o, 0, 1).reshape(B, n * C, H, v.shape[-1])[:, :L]
    return o, S


def layer(x, c, prm, lb, s0, w_buf, buf_k=None, buf_v=None):
    (norm_mix, norm_mlp, w_ada, b_ada, w_in, sinks, hgrn_norm, w_out, w_up, w_down) = prm
    B, L, _ = x.shape
    mod = (jax.nn.silu(c) @ w_ada + b_ada)[:, None, :]
    sh_a, sc_a, g_a, sh_m, sc_m, g_m = jnp.split(mod, N_MOD, axis=-1)

    h = rms_norm(x, norm_mix) * (1.0 + sc_a) + sh_a
    z = h @ w_in
    q, k, v, rq, rf, ri, rg, ga, gr = jnp.split(
        z, np.cumsum(IN_SIZES)[:-1].tolist(), axis=-1)

    q = q.reshape(B, L, N_HEADS, HEAD_DIM)
    k = k.reshape(B, L, N_KV_HEADS, HEAD_DIM)
    v = v.reshape(B, L, N_KV_HEADS, HEAD_DIM)
    if buf_k is None:
        o_attn = swa_prompt(q, k, v, sinks)
        new_k, new_v = k[:, -w_buf:], v[:, -w_buf:]
    else:
        o_attn, new_k, new_v = swa_sample(q, k, v, buf_k, buf_v, sinks)

    fp = rf.astype(jnp.float32).reshape(B, L, REC_HEADS, REC_DK)
    lbh = lb.reshape(REC_HEADS, REC_DK)
    sig = jax.nn.sigmoid(fp)
    logf = jnp.log(lbh + (1.0 - lbh) * sig)
    kr = (1.0 - lbh) * (1.0 - sig)
    qr = jax.nn.silu(rq.astype(jnp.float32)).reshape(B, L, REC_HEADS, REC_DK) * REC_DK ** -0.5
    vr = ri.astype(jnp.float32).reshape(B, L, REC_HEADS, REC_DV)
    o_rec, s_new = hgrn2_chunked(qr, kr, vr, logf, s0.astype(jnp.float32))
    o_rec = rms_norm(o_rec, hgrn_norm.reshape(REC_HEADS, REC_DV)) * jax.nn.silu(
        rg.astype(jnp.float32).reshape(B, L, REC_HEADS, REC_DV))
    o_rec = o_rec.reshape(B, L, D_REC_V).astype(x.dtype)

    mixed = jax.nn.sigmoid(ga) * o_attn + jax.nn.sigmoid(gr) * o_rec
    x = x + g_a * (mixed @ w_out)

    h2 = rms_norm(x, norm_mlp) * (1.0 + sc_m) + sh_m
    x = x + g_m * (jnp.square(jax.nn.relu(h2 @ w_up)) @ w_down)
    return x, new_k, new_v, s_new.astype(s0.dtype)


def setup_inputs(seed: int = 0) -> dict:
    key = jax.random.key(seed)
    ks = jax.random.split(key, 22)
    w_buf = min(WINDOW, PAST_LEN)

    def nrm(k, shape, scale):
        return jax.random.normal(k, shape, jnp.float32) * scale

    return {
        'x_prompt': nrm(ks[0], (BATCH, SEQ, D_MODEL), 1.0),
        'x_sample': nrm(ks[1], (DEC_BATCH, DEC_SEQ, D_MODEL), 1.0),
        'cache_win_k': nrm(ks[2], (DEPTH, DEC_BATCH, w_buf, N_KV_HEADS, HEAD_DIM), 1.0),
        'cache_win_v': nrm(ks[3], (DEPTH, DEC_BATCH, w_buf, N_KV_HEADS, HEAD_DIM), 1.0),
        'state_hgrn': nrm(ks[4], (DEPTH, DEC_BATCH, REC_HEADS, REC_DK, REC_DV), 0.3),
        'c_prompt': nrm(ks[5], (BATCH, D_MODEL), 1.0),
        'c_sample': nrm(ks[6], (DEC_BATCH, D_MODEL), 1.0),
        'norm_mix': 1.0 + nrm(ks[7], (DEPTH, D_MODEL), 0.02),
        'norm_mlp': 1.0 + nrm(ks[8], (DEPTH, D_MODEL), 0.02),
        'w_ada': nrm(ks[9], (DEPTH, D_MODEL, N_MOD * D_MODEL), 0.5 * D_MODEL ** -0.5),
        'b_ada': nrm(ks[10], (DEPTH, N_MOD * D_MODEL), 0.02),
        'w_in': nrm(ks[11], (DEPTH, D_MODEL, IN_COLS), D_MODEL ** -0.5),
        'attn_sinks': nrm(ks[12], (DEPTH, N_HEADS), 0.5),
        'hgrn_lb_logits': nrm(ks[13], (DEPTH, D_REC_K), 0.5),
        'hgrn_norm': 1.0 + nrm(ks[14], (DEPTH, D_REC_V), 0.02),
        'w_out': nrm(ks[15], (DEPTH, D_MODEL, D_MODEL), D_MODEL ** -0.5),
        'w_up': nrm(ks[16], (DEPTH, D_MODEL, D_FF), D_MODEL ** -0.5),
        'w_down': nrm(ks[17], (DEPTH, D_FF, D_MODEL), D_FF ** -0.5),
        'final_norm': 1.0 + nrm(ks[18], (D_MODEL,), 0.02),
    }


def reference(x_prompt, x_sample, cache_win_k, cache_win_v, state_hgrn, c_prompt, c_sample,
              norm_mix, norm_mlp, w_ada, b_ada, w_in, attn_sinks, hgrn_lb_logits, hgrn_norm,
              w_out, w_up, w_down, final_norm):
    w_buf = cache_win_k.shape[2]
    p_lb = jax.nn.softmax(hgrn_lb_logits.astype(jnp.float32), axis=0)
    lb_all = jnp.cumsum(p_lb, axis=0) - p_lb[0]

    xp, xs = x_prompt, x_sample
    pk, pv, ps, sk, sv, ss = [], [], [], [], [], []
    for l in range(DEPTH):
        prm = (norm_mix[l], norm_mlp[l], w_ada[l], b_ada[l], w_in[l], attn_sinks[l],
               hgrn_norm[l], w_out[l], w_up[l], w_down[l])
        s0p = jnp.zeros((xp.shape[0], REC_HEADS, REC_DK, REC_DV), xp.dtype)
        xp, k_p, v_p, s_p = layer(xp, c_prompt, prm, lb_all[l], s0p, w_buf)
        xs, k_s, v_s, s_s = layer(xs, c_sample, prm, lb_all[l], state_hgrn[l], w_buf,
                                  cache_win_k[l], cache_win_v[l])
        pk.append(k_p); pv.append(v_p); ps.append(s_p)
        sk.append(k_s); sv.append(v_s); ss.append(s_s)

    y_prompt = rms_norm(xp, final_norm)
    y_sample = rms_norm(xs, final_norm)
    return (y_prompt, y_sample, jnp.stack(pk), jnp.stack(pv), jnp.stack(ps),
            jnp.stack(sk), jnp.stack(sv), jnp.stack(ss))
```

```cpp
#include <hip/hip_runtime.h>
#include <hip/hip_cooperative_groups.h>
#include <cstdio>
#include <cstdint>
namespace cg = cooperative_groups;
namespace pg8 {
#define PG8_LAS __attribute__((address_space(3)))
typedef unsigned short bf16_t;
typedef short bf16x8 __attribute__((ext_vector_type(8)));
typedef float f32x4 __attribute__((ext_vector_type(4)));
typedef unsigned u32x4 __attribute__((ext_vector_type(4)));
constexpr int BM = 256, BK = 64, HALF = 128, HTB = HALF * BK * 2  , STAGE_BYTES = 8 * HTB, NXCD = 8, WGM = 8;

__host__ __device__ __forceinline__ int lds_byte(int r, int c) { const int st = (r >> 4) * 2 + (c >> 5), rr = r & 15, cc = c & 31, ob = rr * 64 + cc * 2; return st * 1024 + (ob ^ (((ob >> 9) & 1) << 5)); }
__host__ __device__ __forceinline__ void stage_rc(int b, int& R, int& C) { const int st = b / 1024, sb = b % 1024, swz = sb ^ (((sb >> 9) & 1) << 5); R = (st >> 1) * 16 + swz / 64; C = (st & 1) * 32 + (swz % 64) / 2; }
__host__ __device__ __forceinline__ int perm32(int rho) { const int n = rho >> 4, i = rho & 15; return 8 * (i >> 2) + 4 * n + (i & 3); }

struct Unit { int pm, pn, ks; };
struct Gemm { const bf16_t* A; const bf16_t* Bt; int M, N, K, ld; };

struct StaticOrder {
    int nM, nN, nwg, G, c;
    __host__ __device__ void init(int M, int N, int G_, int c_) { nM = M / BM; nN = N / BM; nwg = nM * nN; G = G_; c = c_; }
    __host__ __device__ bool next(int i, Unit& u) const {
        const long L = (long)i * G + c; if (L >= nwg) return false;
        int wgid = (int)L; { const int q = nwg / NXCD, r = nwg % NXCD, xcd = wgid % NXCD, off = wgid / NXCD; wgid = (xcd < r ? xcd * (q + 1) : r * (q + 1) + (xcd - r) * q) + off; }
        const int nig = WGM * nN, gid = wgid / nig, fm = gid * WGM, gsz = (nM - fm) < WGM ? (nM - fm) : WGM;
        u.pm = fm + ((wgid % nig) % gsz); u.pn = (wgid % nig) / gsz; u.ks = 0; return true;
    }
    __device__ __forceinline__ void a_ready(const Unit&) const {}
    __device__ __forceinline__ void done(const Unit&) const {}
};

typedef float f32x2_t __attribute__((ext_vector_type(2)));
typedef __bf16 bf16x2_t __attribute__((ext_vector_type(2)));
__device__ __forceinline__ unsigned cvt_pk_bf16(float lo, float hi) { const f32x2_t v = {lo, hi}; const bf16x2_t b = __builtin_convertvector(v, bf16x2_t); return __builtin_bit_cast(unsigned, b); }

template <class Epi, class Sched, bool ALIGN_EPI = false, bool SP2 = false>
__device__ __forceinline__ void gemm_phase(PG8_LAS unsigned char* lds, const Gemm g, const Sched& S, const Epi& E, const int tid) {
    const int wid = __builtin_amdgcn_readfirstlane(tid >> 6), lane = tid & 63, wr = wid >> 2, wc = wid & 3, fr = lane & 15, fq = lane >> 4;
    const int K = g.K, nt = K / BK, LD = g.ld;
    unsigned voffA[2], voffB[2];
#pragma unroll
    for (int i = 0; i < 2; ++i) { int R, C; stage_rc(tid * 16 + i * 8192, R, C); const int Rb = Epi::PERM ? ((R & ~31) + perm32(R & 31)) : R;
        voffA[i] = (unsigned)(R * LD + C) * 2u; voffB[i] = (unsigned)(Rb * LD + C) * 2u; }
    const size_t kstep = (size_t)(BK * 2);
    const size_t hstep = (size_t)HALF * LD * 2;
    const size_t tstep = 2 * hstep;
    const unsigned ldsw = (unsigned)wid * 1024u;
    const int aoff = lds_byte(wr * 64 + fr, fq * 8), boff = lds_byte(wc * 32 + fr, fq * 8);
#define PG8_SA(b, h) (((b) * 2 + (h)) * HTB)
#define PG8_SB(b, h) ((4 + (b) * 2 + (h)) * HTB)
#define PG8_STAGE(bufoff, gbase, voff) do { _Pragma("unroll") for (int _i = 0; _i < 2; ++_i) \
        __builtin_amdgcn_global_load_lds((const unsigned*)((const char*)(gbase) + (voff)[_i]), (PG8_LAS unsigned*)(lds + (bufoff) + ldsw + _i * 8192), 16, 0, 0); } while (0)
#define PG8_LDA(dst, b, h) do { _Pragma("unroll") for (int m = 0; m < 4; ++m) _Pragma("unroll") for (int k = 0; k < 2; ++k) dst[m][k] = *(const PG8_LAS bf16x8*)(lds + PG8_SA(b, h) + aoff + m * 2048 + k * 1024); } while (0)
#define PG8_LDB(dst, b, h) do { _Pragma("unroll") for (int n = 0; n < 2; ++n) _Pragma("unroll") for (int k = 0; k < 2; ++k) dst[n][k] = *(const PG8_LAS bf16x8*)(lds + PG8_SB(b, h) + boff + n * 2048 + k * 1024); } while (0)
#define PG8_MMA(ai, bj, At, Bt) do { __builtin_amdgcn_s_setprio(1); _Pragma("unroll") for (int m = 0; m < 4; ++m) _Pragma("unroll") for (int n = 0; n < 2; ++n) _Pragma("unroll") for (int k = 0; k < 2; ++k) \
        acc[ai][bj][m][n] = __builtin_amdgcn_mfma_f32_16x16x32_bf16(Bt[n][k], At[m][k], acc[ai][bj][m][n], 0, 0, 0); __builtin_amdgcn_s_setprio(0); } while (0)
#define PG8_WAIT_V(n) asm volatile("s_waitcnt vmcnt(" #n ")" ::: "memory")
#define PG8_WAIT_L(n) asm volatile("s_waitcnt lgkmcnt(" #n ")" ::: "memory")
#define PG8_BAR __builtin_amdgcn_s_barrier()
#define PG8_SCHED __builtin_amdgcn_sched_barrier(0)
    Unit cur, nxt; int ui = 0;
    if (!S.next(0, cur)) return;
    f32x4 acc[2][2][4][2];
#pragma unroll
    for (int a = 0; a < 2; ++a)
#pragma unroll
        for (int b = 0; b < 2; ++b)
#pragma unroll
            for (int m = 0; m < 4; ++m)
#pragma unroll
                for (int n = 0; n < 2; ++n) acc[a][b][m][n] = (f32x4){0.f, 0.f, 0.f, 0.f};
    bf16x8 At[4][2], B0[2][2], B1[2][2];
    const size_t kspl = (size_t)K * 2;
    const char* cA = (const char*)g.A + (size_t)cur.pm * tstep + (size_t)cur.ks * kspl; const char* cB = (const char*)g.Bt + (size_t)cur.pn * tstep + (size_t)cur.ks * kspl;
    S.a_ready(cur);
    if constexpr (SP2) {
        PG8_STAGE(PG8_SB(0, 0), cB, voffB); PG8_STAGE(PG8_SB(0, 1), cB + hstep, voffB); PG8_STAGE(PG8_SA(0, 0), cA, voffA); PG8_STAGE(PG8_SA(0, 1), cA + hstep, voffA);
        if (wr == 1) PG8_BAR;
        PG8_WAIT_V(2); PG8_BAR;
        PG8_STAGE(PG8_SB(1, 0), cB + kstep, voffB); PG8_STAGE(PG8_SA(1, 0), cA + kstep, voffA); PG8_STAGE(PG8_SB(1, 1), cB + hstep + kstep, voffB);
        PG8_WAIT_V(6); PG8_BAR;
    } else {
        PG8_STAGE(PG8_SB(0, 0), cB, voffB); PG8_STAGE(PG8_SA(0, 0), cA, voffA); PG8_STAGE(PG8_SB(0, 1), cB + hstep, voffB); PG8_STAGE(PG8_SA(0, 1), cA + hstep, voffA);
        if (wr == 1) PG8_BAR;
        PG8_WAIT_V(4); PG8_BAR;
        PG8_STAGE(PG8_SB(1, 0), cB + kstep, voffB); PG8_STAGE(PG8_SA(1, 0), cA + kstep, voffA); PG8_STAGE(PG8_SB(1, 1), cB + hstep + kstep, voffB);
        PG8_WAIT_V(6); PG8_BAR;
    }
    for (;;) {
        const bool has_next = S.next(ui + 1, nxt);
        const char* nA = has_next ? (const char*)g.A + (size_t)nxt.pm * tstep + (size_t)nxt.ks * kspl : cA; const char* nB = has_next ? (const char*)g.Bt + (size_t)nxt.pn * tstep + (size_t)nxt.ks * kspl : cB;
        for (int t = 0; t < nt; t += 2) {
            const bool last = (t == nt - 2);
            const char* a1 = cA + (size_t)(t + 1) * kstep;
            const char* a2 = last ? nA : cA + (size_t)(t + 2) * kstep; const char* b2 = last ? nB : cB + (size_t)(t + 2) * kstep;
            const char* a3 = a2 + kstep; const char* b3 = b2 + kstep;
            if (last && has_next) S.a_ready(nxt);
            if constexpr (SP2) {
            PG8_LDB(B0, 0, 0); PG8_LDB(B1, 0, 1); PG8_SCHED; PG8_LDA(At, 0, 0); PG8_STAGE(PG8_SA(1, 1), a1 + hstep, voffA);
            PG8_WAIT_V(8); PG8_WAIT_L(0); PG8_BAR; PG8_MMA(0, 0, At, B0); PG8_MMA(0, 1, At, B1); PG8_BAR; PG8_SCHED;
            PG8_LDA(At, 0, 1); PG8_STAGE(PG8_SB(0, 0), b2, voffB); PG8_STAGE(PG8_SB(0, 1), b2 + hstep, voffB); PG8_STAGE(PG8_SA(0, 0), a2, voffA);
            PG8_WAIT_V(8); PG8_WAIT_L(0); PG8_BAR; PG8_MMA(1, 0, At, B0); PG8_MMA(1, 1, At, B1); PG8_BAR; PG8_SCHED;
            PG8_LDB(B0, 1, 0); PG8_LDB(B1, 1, 1); PG8_SCHED; PG8_LDA(At, 1, 0); PG8_STAGE(PG8_SA(0, 1), a2 + hstep, voffA);
            PG8_WAIT_V(8); PG8_WAIT_L(0); PG8_BAR; PG8_MMA(0, 0, At, B0); PG8_MMA(0, 1, At, B1); PG8_BAR; PG8_SCHED;
            PG8_LDA(At, 1, 1); PG8_STAGE(PG8_SB(1, 0), b3, voffB); PG8_STAGE(PG8_SB(1, 1), b3 + hstep, voffB); PG8_STAGE(PG8_SA(1, 0), a3, voffA);
            PG8_WAIT_V(8); PG8_WAIT_L(0); PG8_BAR; PG8_MMA(1, 0, At, B0); PG8_MMA(1, 1, At, B1); PG8_BAR; PG8_SCHED;
            } else {
            PG8_LDB(B0, 0, 0); PG8_SCHED; PG8_LDA(At, 0, 0); PG8_STAGE(PG8_SA(1, 1), a1 + hstep, voffA);
            PG8_WAIT_L(8); PG8_BAR; PG8_WAIT_L(0); PG8_MMA(0, 0, At, B0); PG8_BAR; PG8_SCHED;
            PG8_LDB(B1, 0, 1); PG8_STAGE(PG8_SB(0, 0), b2, voffB);
            PG8_BAR; PG8_WAIT_L(0); PG8_MMA(0, 1, At, B1); PG8_BAR;
            PG8_LDA(At, 0, 1); PG8_STAGE(PG8_SA(0, 0), a2, voffA);
            PG8_BAR; PG8_WAIT_L(0); PG8_MMA(1, 0, At, B0); PG8_BAR; PG8_SCHED;
            PG8_STAGE(PG8_SB(0, 1), b2 + hstep, voffB);
            PG8_WAIT_V(6); PG8_BAR; PG8_MMA(1, 1, At, B1); PG8_BAR;
            PG8_LDB(B0, 1, 0); PG8_SCHED; PG8_LDA(At, 1, 0); PG8_STAGE(PG8_SA(0, 1), a2 + hstep, voffA);
            PG8_WAIT_L(8); PG8_BAR; PG8_WAIT_L(0); PG8_MMA(0, 0, At, B0); PG8_BAR; PG8_SCHED;
            PG8_LDB(B1, 1, 1); PG8_STAGE(PG8_SB(1, 0), b3, voffB);
            PG8_BAR; PG8_WAIT_L(0); PG8_MMA(0, 1, At, B1); PG8_BAR;
            PG8_LDA(At, 1, 1); PG8_STAGE(PG8_SA(1, 0), a3, voffA);
            PG8_BAR; PG8_WAIT_L(0); PG8_MMA(1, 0, At, B0); PG8_BAR; PG8_SCHED;
            PG8_STAGE(PG8_SB(1, 1), b3 + hstep, voffB);
            PG8_WAIT_V(6); PG8_BAR; PG8_MMA(1, 1, At, B1); PG8_BAR;
            }
        }
        if constexpr (ALIGN_EPI) { if (wr == 0) PG8_BAR; }
        if constexpr (!Epi::AFTER_DRAIN) { E(acc, cur, wr, wc, fr, fq); S.done(cur); }
        if (!has_next) break;
#pragma unroll
        for (int a = 0; a < 2; ++a)
#pragma unroll
            for (int b = 0; b < 2; ++b)
#pragma unroll
                for (int m = 0; m < 4; ++m)
#pragma unroll
                    for (int n = 0; n < 2; ++n) acc[a][b][m][n] = (f32x4){0.f, 0.f, 0.f, 0.f};
        cur = nxt; cA = nA; cB = nB; ++ui;
        if constexpr (ALIGN_EPI) { if (wr == 1) PG8_BAR; }
    }
    PG8_WAIT_V(0);
    if constexpr (!ALIGN_EPI) { if (wr == 0) PG8_BAR; }
    PG8_BAR;
    if constexpr (Epi::AFTER_DRAIN) { E.fused(acc, cur, wr, wc, fr, fq, lds, wid, lane); S.done(cur); }
#undef PG8_SA
#undef PG8_SB
#undef PG8_STAGE
#undef PG8_LDA
#undef PG8_LDB
#undef PG8_MMA
#undef PG8_WAIT_V
#undef PG8_WAIT_L
#undef PG8_BAR
#undef PG8_SCHED
}
}

#define LAS __attribute__((address_space(3)))
#define GB __attribute__((address_space(1)))
#ifndef EN2
#define EN2 31
#endif
#define TIDX fresh_tid(wv_l)
#define BIDX bid_l
#define GDIM G_l
#define LCTX const int wv_l, const int bid_l, const int G_l
#define LARG wv_l, bid_l, G_l
typedef unsigned short bf16_t;
typedef short bf16x8 __attribute__((ext_vector_type(8)));
typedef short s16x4 __attribute__((ext_vector_type(4)));
typedef float f32x4 __attribute__((ext_vector_type(4)));
typedef unsigned u32x4 __attribute__((ext_vector_type(4)));
typedef unsigned u32x2 __attribute__((ext_vector_type(2)));
using pg8::cvt_pk_bf16;

constexpr int DM = 1024, TP = 16384, TS = 1024, TT = TP + TS;
constexpr int NLAYER = 4, INC = 7680, DFF = 4096, NMOD = 6144, MODLD = 4 * NMOD;
constexpr int C_Q = 0, C_K = 1024, C_V = 1280, C_RQ = 1536, C_RF = 2560, C_RI = 3584, C_RG = 4608, C_GA = 5632, C_GR = 6656;
constexpr float EPS = 1e-6f;
constexpr int NTHREADS = 512;
constexpr int LDS_BYTES = 147456;

constexpr size_t O_YP = 0, O_YS = 16777216, O_WKP = 17825792, O_WVP = 18350080, O_HP = 18874368, O_WKS = 20971520, O_WVS = 37748736, O_HS = 54525952;

constexpr size_t al256(size_t x) { return (x + 255) & ~(size_t)255; }
constexpr size_t WS_WIN = 0;
constexpr size_t WS_WOUT = WS_WIN + (size_t)NLAYER * INC * DM * 2;
constexpr size_t WS_WUP = WS_WOUT + (size_t)NLAYER * DM * DM * 2;
constexpr size_t WS_WDN = WS_WUP + (size_t)NLAYER * DFF * DM * 2;
constexpr size_t WS_WADA = WS_WDN + (size_t)NLAYER * DM * DFF * 2;
constexpr size_t WS_AC = WS_WADA + (size_t)NLAYER * NMOD * DM * 2;
constexpr size_t WS_MOD = WS_AC + (size_t)256 * DM * 2;
constexpr size_t WS_LB = WS_MOD + (size_t)256 * MODLD * 4;
constexpr size_t WS_X = WS_LB + (size_t)NLAYER * DM * 4;
constexpr size_t WS_H = WS_X + (size_t)TT * DM * 4;
constexpr size_t WS_MIX = WS_H + (size_t)TT * DM * 2;
constexpr size_t WS_OATT = WS_MIX + (size_t)TT * DM * 2;
constexpr size_t WS_RF = WS_OATT + (size_t)TT * DM * 2;
constexpr size_t WS_OREC = WS_RF + (size_t)TT * DM * 4;
constexpr size_t WS_Z = WS_OREC + (size_t)TT * DM * 4;
constexpr size_t WS_UT = WS_Z + (size_t)TT * INC * 2;
constexpr size_t WS_ST = WS_UT + (size_t)2048 * 16384 * 2;
constexpr size_t WS_DC = WS_ST + (size_t)2048 * 16384 * 2;
constexpr size_t WS_PART = WS_DC + (size_t)2048 * 128 * 4;
constexpr size_t WS_END = WS_PART + (size_t)4 * TS * DM * 4;

struct Params { const float* in[19]; float* out; unsigned char* ws; int ph_lo, ph_hi; };

enum { I_XP = 0, I_XS, I_CK, I_CV, I_ST, I_CP, I_CS, I_NMIX, I_NMLP, I_WADA, I_BADA, I_WIN, I_SINK, I_LBL, I_HNORM, I_WOUT, I_WUP, I_WDN, I_FNORM };

__device__ __forceinline__ int fresh_tid(int wave_s) { int l; asm volatile("v_mbcnt_lo_u32_b32 %0, -1, 0\n\tv_mbcnt_hi_u32_b32 %0, -1, %0" : "=v"(l)); return wave_s * 64 + l; }
template <class T> __device__ __forceinline__ T* uni(T* p) { const unsigned long long v = (unsigned long long)p; const unsigned lo = __builtin_amdgcn_readfirstlane((unsigned)v), hi = __builtin_amdgcn_readfirstlane((unsigned)(v >> 32)); return (T*)(((unsigned long long)hi << 32) | lo); }
__device__ __forceinline__ float bf2f(bf16_t b) { return __uint_as_float((unsigned)b << 16); }
__device__ __forceinline__ float sigmoidf_(float x) { return __frcp_rn(1.0f + __expf(-x)); }
__device__ __forceinline__ float siluf_(float x) { return x * sigmoidf_(x); }
__device__ __forceinline__ int mod_row(int row) { return row < TP ? 128 + (row >> 12) : (row - TP) >> 3; }
__device__ __forceinline__ u32x2 pack4(f32x4 v) { u32x2 r; r.x = cvt_pk_bf16(v[0], v[1]); r.y = cvt_pk_bf16(v[2], v[3]); return r; }

#define EPI_ROWS  _Pragma("unroll") for (int ai = 0; ai < 2; ++ai) _Pragma("unroll") for (int m = 0; m < 4; ++m)
#define EPI_COLS  _Pragma("unroll") for (int bj = 0; bj < 2; ++bj) _Pragma("unroll") for (int n = 0; n < 2; ++n)

struct EpiAda {
    static constexpr bool PERM = false, AFTER_DRAIN = false;
    GB float* mod; const GB float* bias;
    __device__ __forceinline__ void operator()(const f32x4 (&acc)[2][2][4][2], const pg8::Unit& u, int wr, int wc, int fr, int fq) const {
        EPI_ROWS { const int row = u.pm * 256 + ai * 128 + wr * 64 + m * 16 + fr;
            EPI_COLS { const int col = u.pn * 256 + bj * 128 + wc * 32 + n * 16 + 4 * fq;
                *(GB f32x4*)(mod + (size_t)row * MODLD + col) = acc[ai][bj][m][n] + *(const GB f32x4*)(bias + col); } }
    }
};

struct EpiIn {
    static constexpr bool PERM = false, AFTER_DRAIN = false;
    GB bf16_t* Z; GB float* RF; GB float* out; int layer;
    __device__ __forceinline__ void operator()(const f32x4 (&acc)[2][2][4][2], const pg8::Unit& u, int wr, int wc, int fr, int fq) const {
        const int cb = u.pn * 256;
        const int row0 = u.pm * 256 + wr * 64 + fr, col0 = cb + wc * 32 + 4 * fq;
        if (cb >= C_RF && cb < C_RI) {
            GB float* dst = RF + (size_t)row0 * DM + (col0 - C_RF);
            EPI_ROWS { EPI_COLS { *(GB f32x4*)(dst + (size_t)(ai * 128 + m * 16) * DM + bj * 128 + n * 16) = acc[ai][bj][m][n]; } }
        } else if (cb >= C_K && cb < C_RQ) {
            GB bf16_t* dst = Z + (size_t)row0 * INC + col0;
            const int kv = (cb >= C_V) ? 1 : 0, cc0 = col0 - C_K - 256 * kv;
            EPI_ROWS { const int row = row0 + ai * 128 + m * 16;
                GB float* wdst = nullptr;
                if (row >= TP) { const int sr = row - TP; wdst = out + (kv ? O_WVS : O_WKS) + ((size_t)((layer * 128 + (sr >> 3)) * 128 + 120 + (sr & 7))) * 256 + cc0; }
                else if ((row & 4095) >= 3968) wdst = out + (kv ? O_WVP : O_WKP) + ((size_t)((layer * 4 + (row >> 12)) * 128 + ((row & 4095) - 3968))) * 256 + cc0;
                EPI_COLS { const f32x4 v = acc[ai][bj][m][n];
                    *(GB u32x2*)(dst + (size_t)(ai * 128 + m * 16) * INC + bj * 128 + n * 16) = pack4(v);
                    if (wdst) *(GB f32x4*)(wdst + bj * 128 + n * 16) = v; } }
        } else {
            int mode = 0;
            if (cb >= C_RQ && cb < C_RF) mode = 2; else if (cb >= C_RG && cb < C_GA) mode = 4; else if (cb >= C_GA) mode = 5;
            GB bf16_t* dst = Z + (size_t)row0 * INC + col0;
            EPI_ROWS { EPI_COLS { f32x4 v = acc[ai][bj][m][n];
                if (mode != 0) {
#pragma unroll
                    for (int q = 0; q < 4; ++q) { const float sg = sigmoidf_(v[q]); v[q] = mode == 5 ? sg : (mode == 4 ? v[q] * sg : v[q] * sg * 0.08838834764831845f); } }
                *(GB u32x2*)(dst + (size_t)(ai * 128 + m * 16) * INC + bj * 128 + n * 16) = pack4(v); } }
        }
    }
};

struct EpiRes {
    static constexpr bool PERM = false, AFTER_DRAIN = false;
    const GB float* xp; const GB float* xs; GB float* X; const GB float* gate;
    __device__ __forceinline__ void operator()(const f32x4 (&acc)[2][2][4][2], const pg8::Unit& u, int wr, int wc, int fr, int fq) const {
        EPI_ROWS { const int row = u.pm * 256 + ai * 128 + wr * 64 + m * 16 + fr;
            const GB float* xr = row < TP ? xp + (size_t)row * DM : xs + (size_t)(row - TP) * DM;
            const GB float* gr = gate + (size_t)mod_row(row) * MODLD;
            EPI_COLS { const int col = u.pn * 256 + bj * 128 + wc * 32 + n * 16 + 4 * fq;
                const f32x4 xo = *(const GB f32x4*)(xr + col), g = *(const GB f32x4*)(gr + col);
                *(GB f32x4*)(X + (size_t)row * DM + col) = xo + g * acc[ai][bj][m][n]; } }
    }
};

struct EpiPart {
    static constexpr bool PERM = false, AFTER_DRAIN = false;
    GB float* part;
    __device__ __forceinline__ void operator()(const f32x4 (&acc)[2][2][4][2], const pg8::Unit& u, int wr, int wc, int fr, int fq) const {
        GB float* dst = part + ((size_t)u.ks * TS + (size_t)(u.pm * 256 - TP + wr * 64 + fr)) * DM + u.pn * 256 + wc * 32 + 4 * fq;
        EPI_ROWS { EPI_COLS { *(GB f32x4*)(dst + (size_t)(ai * 128 + m * 16) * DM + bj * 128 + n * 16) = acc[ai][bj][m][n]; } }
    }
};
struct SampleSplitOrder {
    int nsplit, G, c;
    __device__ bool next(int i, pg8::Unit& u) const { const int L = i * G + c; if (L >= 16 * nsplit) return false;
        const int t = L / nsplit; u.ks = L - t * nsplit; u.pm = 64 + (t >> 2); u.pn = t & 3; return true; }
    __device__ __forceinline__ void a_ready(const pg8::Unit&) const {}
    __device__ __forceinline__ void done(const pg8::Unit&) const {}
};

struct EpiUp {
    static constexpr bool PERM = false, AFTER_DRAIN = false;
    GB bf16_t* U;
    __device__ __forceinline__ void operator()(const f32x4 (&acc)[2][2][4][2], const pg8::Unit& u, int wr, int wc, int fr, int fq) const {
        EPI_ROWS { const int row = u.pm * 256 + ai * 128 + wr * 64 + m * 16 + fr;
            EPI_COLS { const int col = u.pn * 256 + bj * 128 + wc * 32 + n * 16 + 4 * fq;
                f32x4 v = acc[ai][bj][m][n];
#pragma unroll
                for (int j = 0; j < 4; ++j) { const float r = fmaxf(v[j], 0.f); v[j] = r * r; }
                *(GB u32x2*)(U + (size_t)row * DFF + col) = pack4(v); } }
    }
};

__device__ __forceinline__ void transpose_tile4(LCTX, const float* __restrict__ W, int K, int N, bf16_t* __restrict__ Wt, int tk, int tn0, float* tile) {
    const int tid = TIDX;
    f32x4 v[4][2];
#pragma unroll
    for (int q = 0; q < 4; ++q)
#pragma unroll
        for (int i = 0; i < 2; ++i) { const int idx = tid + i * 512, r = idx >> 4, c4 = (idx & 15) * 4;
            v[q][i] = *(const f32x4*)(W + (size_t)(tk * 64 + r) * N + (tn0 + q) * 64 + c4); }
#pragma unroll
    for (int q = 0; q < 4; ++q)
#pragma unroll
        for (int i = 0; i < 2; ++i) { const int idx = tid + i * 512, r = idx >> 4, c4 = (idx & 15) * 4; float* t_ = tile + q * 4160;
            t_[r * 65 + c4 + 0] = v[q][i][0]; t_[r * 65 + c4 + 1] = v[q][i][1]; t_[r * 65 + c4 + 2] = v[q][i][2]; t_[r * 65 + c4 + 3] = v[q][i][3]; }
    __syncthreads();
    const int n = tid >> 3, k8 = (tid & 7) * 8;
#pragma unroll
    for (int q = 0; q < 4; ++q) { const float* t_ = tile + q * 4160;
        u32x4 w;
        w.x = cvt_pk_bf16(t_[(k8 + 0) * 65 + n], t_[(k8 + 1) * 65 + n]); w.y = cvt_pk_bf16(t_[(k8 + 2) * 65 + n], t_[(k8 + 3) * 65 + n]);
        w.z = cvt_pk_bf16(t_[(k8 + 4) * 65 + n], t_[(k8 + 5) * 65 + n]); w.w = cvt_pk_bf16(t_[(k8 + 6) * 65 + n], t_[(k8 + 7) * 65 + n]);
        *(u32x4*)(Wt + (size_t)((tn0 + q) * 64 + n) * K + tk * 64 + k8) = w; }
    __syncthreads();
}

__device__ __forceinline__ void phase_prologue(LCTX, const Params& P, unsigned char* lds) {
    unsigned char* ws = uni(P.ws);
    float* tile = (float*)lds;
    constexpr int N_IN = 16 * 120, N_OUT = 16 * 16, N_UP = 16 * 64, N_DN = 64 * 16, N_ADA = 16 * 96, PER_L = N_IN + N_OUT + N_UP + N_DN + N_ADA;
    for (int item = 4 * BIDX; item < NLAYER * PER_L; item += 4 * GDIM) {
        const int l = item / PER_L; int r = item % PER_L;
        if (r < N_IN) { transpose_tile4(LARG, uni(P.in[I_WIN]) + (size_t)l * DM * INC, DM, INC, (bf16_t*)(ws + WS_WIN) + (size_t)l * INC * DM, r / 120, r % 120, tile); continue; }
        r -= N_IN;
        if (r < N_OUT) { transpose_tile4(LARG, uni(P.in[I_WOUT]) + (size_t)l * DM * DM, DM, DM, (bf16_t*)(ws + WS_WOUT) + (size_t)l * DM * DM, r / 16, r % 16, tile); continue; }
        r -= N_OUT;
        if (r < N_UP) { transpose_tile4(LARG, uni(P.in[I_WUP]) + (size_t)l * DM * DFF, DM, DFF, (bf16_t*)(ws + WS_WUP) + (size_t)l * DFF * DM, r / 64, r % 64, tile); continue; }
        r -= N_UP;
        if (r < N_DN) { transpose_tile4(LARG, uni(P.in[I_WDN]) + (size_t)l * DFF * DM, DFF, DM, (bf16_t*)(ws + WS_WDN) + (size_t)l * DM * DFF, r / 16, r % 16, tile); continue; }
        r -= N_DN;
        transpose_tile4(LARG, uni(P.in[I_WADA]) + (size_t)l * DM * NMOD, DM, NMOD, (bf16_t*)(ws + WS_WADA) + (size_t)l * NMOD * DM, r / 96, r % 96, tile);
    }
    bf16_t* AC = (bf16_t*)(ws + WS_AC);
    for (int idx = BIDX * NTHREADS + TIDX; idx < 256 * DM / 4; idx += GDIM * NTHREADS) {
        const int row = idx >> 8, c4 = (idx & 255) * 4;
        f32x4 v = {0.f, 0.f, 0.f, 0.f};
        if (row < 128) v = *(const f32x4*)(uni(P.in[I_CS]) + (size_t)row * DM + c4);
        else if (row < 132) v = *(const f32x4*)(uni(P.in[I_CP]) + (size_t)(row - 128) * DM + c4);
        v[0] = siluf_(v[0]); v[1] = siluf_(v[1]); v[2] = siluf_(v[2]); v[3] = siluf_(v[3]);
        *(u32x2*)(AC + (size_t)row * DM + c4) = pack4(v);
    }
    float* LB = (float*)(ws + WS_LB);
    for (int ch = BIDX * NTHREADS + TIDX; ch < DM; ch += GDIM * NTHREADS) {
        const float* lg = uni(P.in[I_LBL]);
        const float a0 = lg[ch], a1 = lg[DM + ch], a2 = lg[2 * DM + ch], a3 = lg[3 * DM + ch];
        const float mx = fmaxf(fmaxf(a0, a1), fmaxf(a2, a3));
        const float e0 = __expf(a0 - mx), e1 = __expf(a1 - mx), e2 = __expf(a2 - mx), e3 = __expf(a3 - mx);
        const float inv = 1.0f / (e0 + e1 + e2 + e3);
        LB[ch] = 0.f; LB[DM + ch] = e1 * inv; LB[2 * DM + ch] = (e1 + e2) * inv; LB[3 * DM + ch] = (e1 + e2 + e3) * inv;
    }
}

__device__ __forceinline__ void phase_norm(LCTX, const Params& P, int layer, int which) {
    unsigned char* ws = uni(P.ws);
    const int tid = TIDX; const int lane = tid & 63, wave = tid >> 6;
    const float* X = (const float*)(ws + WS_X);
    const float* mod = (const float*)(ws + WS_MOD);
    bf16_t* H = (bf16_t*)(ws + WS_H);
    const float* gw = which == 0 ? uni(P.in[I_NMIX]) + layer * DM : which == 1 ? uni(P.in[I_NMLP]) + layer * DM : uni(P.in[I_FNORM]);
    for (int row = BIDX * 8 + wave; row < TT; row += GDIM * 8) {
        const float* xr = (layer == 0 && which == 0) ? (row < TP ? uni(P.in[I_XP]) + (size_t)row * DM : uni(P.in[I_XS]) + (size_t)(row - TP) * DM) : X + (size_t)row * DM;
        f32x4 v[4]; float ss = 0.f;
#pragma unroll
        for (int i = 0; i < 4; ++i) v[i] = *(const f32x4*)(xr + i * 256 + lane * 4);
        if (row >= TP && !(layer == 0 && which == 0)) {
            const int nsl = which == 1 ? 2 : 4, gl = which == 1 ? layer : (which == 2 ? NLAYER - 1 : layer - 1);
            const float* gp = mod + (size_t)mod_row(row) * MODLD + gl * NMOD + (which == 1 ? 2 : 5) * DM;
            const float* pp_ = (const float*)(ws + WS_PART) + (size_t)(row - TP) * DM;
#pragma unroll
            for (int i = 0; i < 4; ++i) { const int c = i * 256 + lane * 4; f32x4 a = *(const f32x4*)(pp_ + c);
                for (int s2 = 1; s2 < nsl; ++s2) a += *(const f32x4*)(pp_ + (size_t)s2 * TS * DM + c);
                v[i] += *(const f32x4*)(gp + c) * a;
                *(f32x4*)((float*)(ws + WS_X) + (size_t)row * DM + c) = v[i]; }
        }
#pragma unroll
        for (int i = 0; i < 4; ++i) { ss += v[i][0] * v[i][0] + v[i][1] * v[i][1] + v[i][2] * v[i][2] + v[i][3] * v[i][3]; }
#pragma unroll
        for (int o = 1; o < 64; o <<= 1) ss += __shfl_xor(ss, o);
        const float r = rsqrtf(ss * (1.0f / DM) + EPS);
        if (layer == 0 && which == 0 && row >= TP) {
#pragma unroll
            for (int i = 0; i < 4; ++i) *(f32x4*)((float*)(ws + WS_X) + (size_t)row * DM + i * 256 + lane * 4) = v[i]; }
        if (which == 2) {
#pragma unroll
            for (int i = 0; i < 4; ++i) { const int c = i * 256 + lane * 4; const f32x4 g = *(const f32x4*)(gw + c);
                *(f32x4*)(uni(P.out) + (size_t)row * DM + c) = v[i] * r * g; }
        } else {
            const float* mr = mod + (size_t)mod_row(row) * MODLD + layer * NMOD + (which ? 3 : 0) * DM;
#pragma unroll
            for (int i = 0; i < 4; ++i) { const int c = i * 256 + lane * 4; const f32x4 g = *(const f32x4*)(gw + c);
                const f32x4 sh = *(const f32x4*)(mr + c), sc = *(const f32x4*)(mr + DM + c);
                const f32x4 h = (v[i] * r * g) * (sc + 1.0f) + sh;
                *(u32x2*)(H + (size_t)row * DM + c) = pack4(h); }
        }
    }
}

struct KLdsLoader { const unsigned char* ks; int fr, g, kbase;
    __device__ __forceinline__ bf16x8 get(int kt, int kk) const { return *(const bf16x8*)(ks + (kbase + 16 * kt + fr) * 144 + (g * 8 + 32 * kk) * 2); } };
struct VLdsLoader { const unsigned char* vt; int fr, g, kbase;
    __device__ __forceinline__ bf16x8 get(int dt, int c) const {
        const int d_ = 16 * dt + fr;
        const unsigned char* p = vt + d_ * 528 + (((kbase + 32 * c + 4 * g) ^ (((d_ >> 3) & 7) << 2))) * 2;
        const unsigned char* p2 = vt + d_ * 528 + (((kbase + 32 * c + 16 + 4 * g) ^ (((d_ >> 3) & 7) << 2))) * 2;
        const s16x4 a = *(const s16x4*)p, b = *(const s16x4*)p2;
        bf16x8 r; r[0] = a[0]; r[1] = a[1]; r[2] = a[2]; r[3] = a[3]; r[4] = b[0]; r[5] = b[1]; r[6] = b[2]; r[7] = b[3]; return r; } };
template <class KL, class VL>
__device__ __forceinline__ void attn_task(const KL& kl, const VL& vl, const bf16x8 qf0, const bf16x8 qf1, int iq, float slope, float sink, int kbase, int dmax, bf16_t* orow, int g) {
    f32x4 s[10];
#pragma unroll
    for (int kt = 0; kt < 10; ++kt) { const bf16x8 k0 = kl.get(kt, 0), k1 = kl.get(kt, 1);
        f32x4 a = {0.f, 0.f, 0.f, 0.f};
        a = __builtin_amdgcn_mfma_f32_16x16x32_bf16(k0, qf0, a, 0, 0, 0);
        a = __builtin_amdgcn_mfma_f32_16x16x32_bf16(k1, qf1, a, 0, 0, 0); s[kt] = a; }
    float mx = sink;
    const int dbase = iq + 128 - kbase - 4 * g;
#pragma unroll
    for (int kt = 0; kt < 10; ++kt)
#pragma unroll
        for (int r = 0; r < 4; ++r) { const int dist = dbase - 16 * kt - r;
            const float v = ((unsigned)dist <= (unsigned)dmax) ? s[kt][r] * 0.125f - slope * (float)dist : -1e30f;
            s[kt][r] = v; mx = fmaxf(mx, v); }
    mx = fmaxf(mx, __shfl_xor(mx, 16)); mx = fmaxf(mx, __shfl_xor(mx, 32));
    float l = 0.f;
#pragma unroll
    for (int kt = 0; kt < 10; ++kt)
#pragma unroll
        for (int r = 0; r < 4; ++r) { const float p = __expf(s[kt][r] - mx); s[kt][r] = p; l += p; }
    l += __shfl_xor(l, 16); l += __shfl_xor(l, 32);
    l += __expf(sink - mx);
    const float inv = 1.0f / l;
    f32x4 o[4];
#pragma unroll
    for (int dt = 0; dt < 4; ++dt) o[dt] = (f32x4){0.f, 0.f, 0.f, 0.f};
#pragma unroll
    for (int c = 0; c < 5; ++c) {
        const unsigned w0 = cvt_pk_bf16(s[2 * c][0], s[2 * c][1]), w1 = cvt_pk_bf16(s[2 * c][2], s[2 * c][3]);
        const unsigned w2 = cvt_pk_bf16(s[2 * c + 1][0], s[2 * c + 1][1]), w3 = cvt_pk_bf16(s[2 * c + 1][2], s[2 * c + 1][3]);
        bf16x8 pf; pf[0] = (short)(w0 & 0xffff); pf[1] = (short)(w0 >> 16); pf[2] = (short)(w1 & 0xffff); pf[3] = (short)(w1 >> 16); pf[4] = (short)(w2 & 0xffff); pf[5] = (short)(w2 >> 16); pf[6] = (short)(w3 & 0xffff); pf[7] = (short)(w3 >> 16);
#pragma unroll
        for (int dt = 0; dt < 4; ++dt) { const bf16x8 vf = vl.get(dt, c); o[dt] = __builtin_amdgcn_mfma_f32_16x16x32_bf16(vf, pf, o[dt], 0, 0, 0); }
    }
#pragma unroll
    for (int dt = 0; dt < 4; ++dt) *(u32x2*)(orow + 16 * dt + 4 * g) = pack4(o[dt] * inv);
}

__device__ __forceinline__ float alibi_slope(int h) { return exp2f(-0.5f * (float)(h + 1)); }

__device__ __forceinline__ void attn_prompt_item(LCTX, const Params& P, int layer, int item, unsigned char* lds) {
    unsigned char* ws = uni(P.ws);
    const bf16_t* Z = (const bf16_t*)(ws + WS_Z);
    bf16_t* OATT = (bf16_t*)(ws + WS_OATT);
    const int kvh = item & 3, j = (item >> 2) & 31, b = item >> 7;
    int tid = TIDX; asm volatile("" : "+v"(tid));
    const int lane = tid & 63, wave = tid >> 6, fr = lane & 15, g = lane >> 4;
    unsigned char* ks = lds; unsigned char* vt = lds + 256 * 144;
    const int row0 = b * 4096 + (j - 1) * 128;
    u32x4 kqa[4], vqa[4];
#pragma unroll
    for (int it = 0; it < 4; ++it) { const int p = tid + it * 512, key = p >> 3, d8 = (p & 7) * 8;
        kqa[it] = (u32x4){0u, 0u, 0u, 0u}; vqa[it] = (u32x4){0u, 0u, 0u, 0u};
        if (j > 0 || key >= 128) { const bf16_t* zr = Z + (size_t)(row0 + key) * INC + kvh * 64 + d8; kqa[it] = *(const u32x4*)(zr + C_K); vqa[it] = *(const u32x4*)(zr + C_V); } }
#pragma unroll
    for (int it = 0; it < 4; ++it) { const int p = tid + it * 512, key = p >> 3, d8 = (p & 7) * 8;
        const u32x4 kq = kqa[it], vq = vqa[it];
        *(u32x4*)(ks + key * 144 + d8 * 2) = kq;
        bf16_t* vp = (bf16_t*)(vt + d8 * 528 + (key ^ ((p & 7) << 2)) * 2);
        vp[0 * 264] = (bf16_t)(vq.x & 0xffff); vp[1 * 264] = (bf16_t)(vq.x >> 16); vp[2 * 264] = (bf16_t)(vq.y & 0xffff); vp[3 * 264] = (bf16_t)(vq.y >> 16);
        vp[4 * 264] = (bf16_t)(vq.z & 0xffff); vp[5 * 264] = (bf16_t)(vq.z >> 16); vp[6 * 264] = (bf16_t)(vq.w & 0xffff); vp[7 * 264] = (bf16_t)(vq.w >> 16); }
    __syncthreads();
#pragma unroll 1
    for (int it = 0; it < 4; ++it) {
        const int task = wave + 8 * it, gh = task >> 3, i0 = (task & 7) * 16, h = kvh * 4 + gh;
        const int kbase = i0 < 96 ? i0 : 96;
        const size_t r = (size_t)(b * 4096 + j * 128 + i0 + fr);
        const bf16x8 qf0 = *(const bf16x8*)(Z + r * INC + h * 64 + g * 8), qf1 = *(const bf16x8*)(Z + r * INC + h * 64 + 32 + g * 8);
        const int iq = i0 + fr, dmax = j > 0 ? 128 : iq;
        KLdsLoader kl{ks, fr, g, kbase}; VLdsLoader vl{vt, fr, g, kbase};
        attn_task(kl, vl, qf0, qf1, iq, alibi_slope(h), uni(P.in[I_SINK])[layer * 16 + h], kbase, dmax, OATT + r * DM + h * 64, g);
    }
    __syncthreads();
}

__device__ __forceinline__ void attn_sample_item(LCTX, const Params& P, int layer, int item, unsigned char* lds) {
    unsigned char* ws = uni(P.ws);
    const bf16_t* Z = (const bf16_t*)(ws + WS_Z);
    bf16_t* OATT = (bf16_t*)(ws + WS_OATT);
    const int kvh = item & 3, b = item >> 2;
    int tid = TIDX; asm volatile("" : "+v"(tid));
    const int lane = tid & 63, wave = tid >> 6, fr = lane & 15, g = lane >> 4;
    unsigned char* ks = lds; unsigned char* vt = lds + 256 * 144;
    const size_t cbase = ((size_t)(layer * 128 + b) * 128) * 256 + kvh * 64;
    const float* ck = uni(P.in[I_CK]) + cbase; const float* cv = uni(P.in[I_CV]) + cbase;
    float* wk = uni(P.out) + O_WKS + cbase; float* wv = uni(P.out) + O_WVS + cbase;
    const size_t zrow0 = (size_t)(TP + b * 8);
#pragma unroll 1
    for (int p = tid; p < 160 * 8; p += 512) { const int key = p >> 3, d8 = (p & 7) * 8;
        u32x4 kq = {0u, 0u, 0u, 0u}, vq = {0u, 0u, 0u, 0u};
        if (key < 128) {
            const f32x4 k0 = *(const f32x4*)(ck + (size_t)key * 256 + d8), k1 = *(const f32x4*)(ck + (size_t)key * 256 + d8 + 4);
            const f32x4 v0 = *(const f32x4*)(cv + (size_t)key * 256 + d8), v1 = *(const f32x4*)(cv + (size_t)key * 256 + d8 + 4);
            if (key >= 8) { *(f32x4*)(wk + (size_t)(key - 8) * 256 + d8) = k0; *(f32x4*)(wk + (size_t)(key - 8) * 256 + d8 + 4) = k1;
                            *(f32x4*)(wv + (size_t)(key - 8) * 256 + d8) = v0; *(f32x4*)(wv + (size_t)(key - 8) * 256 + d8 + 4) = v1; }
            kq.x = cvt_pk_bf16(k0[0], k0[1]); kq.y = cvt_pk_bf16(k0[2], k0[3]); kq.z = cvt_pk_bf16(k1[0], k1[1]); kq.w = cvt_pk_bf16(k1[2], k1[3]);
            vq.x = cvt_pk_bf16(v0[0], v0[1]); vq.y = cvt_pk_bf16(v0[2], v0[3]); vq.z = cvt_pk_bf16(v1[0], v1[1]); vq.w = cvt_pk_bf16(v1[2], v1[3]);
        } else if (key < 136) { const bf16_t* zr = Z + (zrow0 + (key - 128)) * INC + kvh * 64 + d8; kq = *(const u32x4*)(zr + C_K); vq = *(const u32x4*)(zr + C_V); }
        *(u32x4*)(ks + key * 144 + d8 * 2) = kq;
        bf16_t* vp = (bf16_t*)(vt + d8 * 528 + (key ^ ((p & 7) << 2)) * 2);
        vp[0 * 264] = (bf16_t)(vq.x & 0xffff); vp[1 * 264] = (bf16_t)(vq.x >> 16); vp[2 * 264] = (bf16_t)(vq.y & 0xffff); vp[3 * 264] = (bf16_t)(vq.y >> 16);
        vp[4 * 264] = (bf16_t)(vq.z & 0xffff); vp[5 * 264] = (bf16_t)(vq.z >> 16); vp[6 * 264] = (bf16_t)(vq.w & 0xffff); vp[7 * 264] = (bf16_t)(vq.w >> 16); }
    __syncthreads();
    if (wave < 2) {
        const int qt = wave, gh = 2 * qt + (fr >> 3), qi = fr & 7, h = kvh * 4 + gh; const size_t r = zrow0 + qi;
        const bf16x8 qf0 = *(const bf16x8*)(Z + r * INC + h * 64 + g * 8), qf1 = *(const bf16x8*)(Z + r * INC + h * 64 + 32 + g * 8);
        KLdsLoader kl{ks, fr, g, 0}; VLdsLoader vl{vt, fr, g, 0};
        attn_task(kl, vl, qf0, qf1, qi, alibi_slope(h), uni(P.in[I_SINK])[layer * 16 + h], 0, 128, OATT + r * DM + h * 64, g);
    }
    __syncthreads();
}

__device__ __forceinline__ void hgrn_sample_item(LCTX, const Params& P, int layer, int item, unsigned char* lds) {
    unsigned char* ws = uni(P.ws);
    const bf16_t* Z = (const bf16_t*)(ws + WS_Z);
    const float* RF = (const float*)(ws + WS_RF);
    float* OREC = (float*)(ws + WS_OREC);
    int tid = TIDX; asm volatile("" : "+v"(tid));
    const int b = item >> 3, h = item & 7, rowbase = TP + b * 8;
    const float* LB = (const float*)(ws + WS_LB) + layer * DM + h * 128;
    const float* s0 = uni(P.in[I_ST]) + ((size_t)((layer * 128 + b) * 8 + h)) * 16384;
    float* sout = uni(P.out) + O_HS + ((size_t)((layer * 128 + b) * 8 + h)) * 16384;
    float* F = (float*)lds; float* KR = F + 1024; float* QR = KR + 1024; float* VV = QR + 1024; float* PO = VV + 1024;
    const int v = tid & 127, kg = tid >> 7, k0 = kg * 32;
    float S[32];
#pragma unroll
    for (int i = 0; i < 32; ++i) S[i] = s0[(size_t)(k0 + i) * 128 + v];
    float rfv[2], lbv[2]; unsigned qv2[2], vv2[2];
#pragma unroll
    for (int e = 0; e < 2; ++e) { const int idx = tid + e * 512, t = idx >> 7, k = idx & 127; const size_t row = (size_t)(rowbase + t);
        rfv[e] = RF[row * DM + h * 128 + k]; lbv[e] = LB[k]; qv2[e] = Z[row * INC + C_RQ + h * 128 + k]; vv2[e] = Z[row * INC + C_RI + h * 128 + k]; }
#pragma unroll
    for (int e = 0; e < 2; ++e) { const int idx = tid + e * 512; const float sg = sigmoidf_(rfv[e]), om = 1.0f - lbv[e];
        F[idx] = lbv[e] + om * sg; KR[idx] = om * (1.0f - sg); QR[idx] = bf2f((bf16_t)qv2[e]); VV[idx] = bf2f((bf16_t)vv2[e]); }
    __syncthreads();
#pragma unroll 1
    for (int t = 0; t < 8; ++t) {
        const float vv = VV[t * 128 + v]; float acc = 0.f;
#pragma unroll
        for (int i4 = 0; i4 < 8; ++i4) {
            const f32x4 f = *(const f32x4*)(F + t * 128 + k0 + 4 * i4), c = *(const f32x4*)(KR + t * 128 + k0 + 4 * i4), q = *(const f32x4*)(QR + t * 128 + k0 + 4 * i4);
#pragma unroll
            for (int j = 0; j < 4; ++j) { S[4 * i4 + j] = f[j] * S[4 * i4 + j] + c[j] * vv; acc += S[4 * i4 + j] * q[j]; }
        }
        PO[(t * 4 + kg) * 128 + v] = acc;
    }
    __syncthreads();
#pragma unroll
    for (int e = 0; e < 2; ++e) { const int idx = tid + e * 512, t = idx >> 7, v2 = idx & 127;
        OREC[(size_t)(rowbase + t) * DM + h * 128 + v2] = (PO[(t * 4 + 0) * 128 + v2] + PO[(t * 4 + 1) * 128 + v2]) + (PO[(t * 4 + 2) * 128 + v2] + PO[(t * 4 + 3) * 128 + v2]); }
#pragma unroll
    for (int i = 0; i < 32; ++i) sout[(size_t)(k0 + i) * 128 + v] = S[i];
    __syncthreads();
}

__device__ __forceinline__ bf16_t f2bf1(float x) { return (bf16_t)(cvt_pk_bf16(x, 0.f) & 0xffffu); }

__device__ __forceinline__ void hg_prep(const GB float* __restrict__ RF, const GB float* __restrict__ LBh, int r0, int h, int k, int seg, float* segt, float (&loc)[16], float (&kr)[16], float (&tot)[4]) {
    const float lb = LBh[k], om = 1.0f - lb;
    float rf[16];
#pragma unroll
    for (int i = 0; i < 16; ++i) rf[i] = RF[(size_t)(r0 + seg * 16 + i) * DM + h * 128 + k];
    float run = 0.f;
#pragma unroll
    for (int i = 0; i < 16; ++i) { const float sg = sigmoidf_(rf[i]); const float f = fmaxf(lb + om * sg, 1e-30f); run += __logf(f); loc[i] = run; kr[i] = om * (1.0f - sg); }
    segt[seg * 128 + k] = run;
    __syncthreads();
#pragma unroll
    for (int s2 = 0; s2 < 4; ++s2) tot[s2] = segt[s2 * 128 + k];
}

__device__ __forceinline__ void hgrn_local_item(LCTX, const Params& P, int layer, int item, unsigned char* lds) {
    unsigned char* ws = uni(P.ws);
    const GB bf16_t* Z = (const GB bf16_t*)(ws + WS_Z);
    int tid = TIDX; asm volatile("" : "+v"(tid));
    const int k = tid & 127, seg = tid >> 7, lane = tid & 63, w = tid >> 6, fr = lane & 15, g = lane >> 4;
    const int b = item >> 9, c = (item >> 3) & 63, h = item & 7, r0 = b * 4096 + c * 64;
    unsigned char* KT = lds; unsigned char* VT = lds + 18432; float* segt = (float*)(lds + 36864);
    unsigned vv[16];
#pragma unroll
    for (int i = 0; i < 16; ++i) vv[i] = Z[(size_t)(r0 + seg * 16 + i) * INC + C_RI + h * 128 + k];
    float loc[16], kr[16], tot[4];
    hg_prep((const GB float*)(ws + WS_RF), (const GB float*)(ws + WS_LB) + layer * DM + h * 128, r0, h, k, seg, segt, loc, kr, tot);
    float after = 0.f;
#pragma unroll
    for (int s2 = 1; s2 < 4; ++s2) if (s2 > seg) after += tot[s2];
    const float endl = after + loc[15];
    {   u32x4 w0, w1; float e[16];
#pragma unroll
        for (int i = 0; i < 16; ++i) e[i] = kr[i] * __expf(endl - loc[i]);
        w0.x = cvt_pk_bf16(e[0], e[1]); w0.y = cvt_pk_bf16(e[2], e[3]); w0.z = cvt_pk_bf16(e[4], e[5]); w0.w = cvt_pk_bf16(e[6], e[7]);
        w1.x = cvt_pk_bf16(e[8], e[9]); w1.y = cvt_pk_bf16(e[10], e[11]); w1.z = cvt_pk_bf16(e[12], e[13]); w1.w = cvt_pk_bf16(e[14], e[15]);
        *(u32x4*)(KT + k * 144 + seg * 32) = w0; *(u32x4*)(KT + k * 144 + seg * 32 + 16) = w1; }
    {   u32x4 w0, w1;
        w0.x = vv[0] | (vv[1] << 16); w0.y = vv[2] | (vv[3] << 16); w0.z = vv[4] | (vv[5] << 16); w0.w = vv[6] | (vv[7] << 16);
        w1.x = vv[8] | (vv[9] << 16); w1.y = vv[10] | (vv[11] << 16); w1.z = vv[12] | (vv[13] << 16); w1.w = vv[14] | (vv[15] << 16);
        *(u32x4*)(VT + k * 144 + seg * 32) = w0; *(u32x4*)(VT + k * 144 + seg * 32 + 16) = w1; }
    if (seg == 0) ((GB float*)(ws + WS_DC))[(size_t)item * 128 + k] = __expf(tot[0] + tot[1] + tot[2] + tot[3]);
    __syncthreads();
    const bf16x8 a0 = *(const bf16x8*)(KT + (16 * w + fr) * 144 + 16 * g), a1 = *(const bf16x8*)(KT + (16 * w + fr) * 144 + 16 * g + 64);
    GB bf16_t* UT = (GB bf16_t*)(ws + WS_UT) + (size_t)item * 16384;
#pragma unroll
    for (int nt = 0; nt < 8; ++nt) {
        const bf16x8 b0 = *(const bf16x8*)(VT + (16 * nt + fr) * 144 + 16 * g), b1 = *(const bf16x8*)(VT + (16 * nt + fr) * 144 + 16 * g + 64);
        f32x4 acc = {0.f, 0.f, 0.f, 0.f};
        acc = __builtin_amdgcn_mfma_f32_16x16x32_bf16(a0, b0, acc, 0, 0, 0);
        acc = __builtin_amdgcn_mfma_f32_16x16x32_bf16(a1, b1, acc, 0, 0, 0);
        *(GB u32x2*)(UT + (16 * nt + fr) * 128 + 16 * w + 4 * g) = pack4(acc);
    }
    __syncthreads();
}

__device__ __forceinline__ void phase_scan(LCTX, const Params& P, int layer, unsigned char* lds) {
    unsigned char* ws = uni(P.ws);
    int tid = TIDX; asm volatile("" : "+v"(tid));
    const GB bf16_t* __restrict__ UT = (const GB bf16_t*)(ws + WS_UT); const GB float* __restrict__ DC = (const GB float*)(ws + WS_DC); GB bf16_t* __restrict__ ST = (GB bf16_t*)(ws + WS_ST);
    float* tile = (float*)lds;
    for (int base = BIDX * 512; base < 32 * 128 * 32; base += GDIM * 512) {
        const int idx = base + tid, p = idx >> 12, v = (idx >> 5) & 127, kq = idx & 31, b = p >> 3, h = p & 7;
        f32x4 S = {0.f, 0.f, 0.f, 0.f};
        size_t item = (size_t)(b * 64) * 8 + h;
#pragma unroll 8
        for (int c = 0; c < 64; ++c, item += 8) {
            *(GB u32x2*)(ST + item * 16384 + v * 128 + 4 * kq) = pack4(S);
            const f32x4 d = *(const GB f32x4*)(DC + item * 128 + 4 * kq); const u32x2 uw = *(const GB u32x2*)(UT + item * 16384 + v * 128 + 4 * kq);
            const f32x4 u = {__uint_as_float(uw.x << 16), __uint_as_float(uw.x & 0xffff0000u), __uint_as_float(uw.y << 16), __uint_as_float(uw.y & 0xffff0000u)};
            S = d * S + u;
        }
        const int vl = (tid >> 5);
        tile[(4 * kq + 0) * 17 + vl] = S[0]; tile[(4 * kq + 1) * 17 + vl] = S[1]; tile[(4 * kq + 2) * 17 + vl] = S[2]; tile[(4 * kq + 3) * 17 + vl] = S[3];
        __syncthreads();
        const int kk = tid >> 2, v4 = (tid & 3) * 4, vb = v - vl;
        f32x4 o; o[0] = tile[kk * 17 + v4]; o[1] = tile[kk * 17 + v4 + 1]; o[2] = tile[kk * 17 + v4 + 2]; o[3] = tile[kk * 17 + v4 + 3];
        *(GB f32x4*)((GB float*)uni(P.out) + O_HP + ((size_t)((layer * 4 + b) * 8 + h)) * 16384 + (size_t)kk * 128 + vb + v4) = o;
        __syncthreads();
    }
}

struct MergeOps { bf16x8 sg[2], sa[2], sr[2], oa[2]; f32x4 hn[4]; };
__device__ __forceinline__ void merge_load(const Params& P, int layer, int row, int c0, MergeOps& m) {
    unsigned char* ws = uni(P.ws);
    const GB bf16_t* zr = (const GB bf16_t*)(ws + WS_Z) + (size_t)row * INC + c0;
    const GB bf16_t* oar = (const GB bf16_t*)(ws + WS_OATT) + (size_t)row * DM + c0;
    const GB float* hn = (const GB float*)uni(P.in[I_HNORM]) + layer * DM + c0;
#pragma unroll
    for (int hf = 0; hf < 2; ++hf) { m.sg[hf] = *(const GB bf16x8*)(zr + C_RG + 8 * hf); m.sa[hf] = *(const GB bf16x8*)(zr + C_GA + 8 * hf); m.sr[hf] = *(const GB bf16x8*)(zr + C_GR + 8 * hf);
        m.oa[hf] = *(const GB bf16x8*)(oar + 8 * hf); }
#pragma unroll
    for (int i = 0; i < 4; ++i) m.hn[i] = *(const GB f32x4*)(hn + 4 * i);
}
__device__ __forceinline__ void merge_store(const Params& P, int row, int c0, const float (&o)[16], float r, const MergeOps& mo) {
    unsigned char* ws = uni(P.ws);
    GB bf16_t* mr = (GB bf16_t*)(ws + WS_MIX) + (size_t)row * DM + c0;
#pragma unroll
    for (int hf = 0; hf < 2; ++hf) {
        float m[8];
#pragma unroll
        for (int i = 0; i < 8; ++i) { const float orec = o[8 * hf + i] * r * mo.hn[2 * hf + (i >> 2)][i & 3] * bf2f((bf16_t)mo.sg[hf][i]);
            m[i] = bf2f((bf16_t)mo.sa[hf][i]) * bf2f((bf16_t)mo.oa[hf][i]) + bf2f((bf16_t)mo.sr[hf][i]) * orec; }
        u32x4 ow; ow.x = cvt_pk_bf16(m[0], m[1]); ow.y = cvt_pk_bf16(m[2], m[3]); ow.z = cvt_pk_bf16(m[4], m[5]); ow.w = cvt_pk_bf16(m[6], m[7]);
        *(GB u32x4*)(mr + 8 * hf) = ow;
    }
}

__device__ __forceinline__ void hgrn_out_item(LCTX, const Params& P, int layer, int item, unsigned char* lds) {
    unsigned char* ws = uni(P.ws);
    const GB bf16_t* Z = (const GB bf16_t*)(ws + WS_Z);
    int tid = TIDX; asm volatile("" : "+v"(tid));
    const int k = tid & 127, seg = tid >> 7, lane = tid & 63, w = tid >> 6, fr = lane & 15, g = lane >> 4;
    const int b = item >> 9, c = (item >> 3) & 63, h = item & 7, r0 = b * 4096 + c * 64;
    unsigned char* QT = lds; unsigned char* ATT = lds + 17408; unsigned char* VT = lds + 26624; unsigned char* QH = lds + 45056; unsigned char* QD = lds + 62464;
    unsigned char* KD = lds + 79872; unsigned char* KH = lds + 97280; float* segt = (float*)(lds + 123392); float* OS = (float*)(lds + 45056);
    unsigned vv[16], qv[16]; bf16x8 bs[4]; MergeOps mo;
    merge_load(P, layer, r0 + (tid >> 3), h * 128 + (tid & 7) * 16, mo);
#pragma unroll
    for (int i = 0; i < 16; ++i) { vv[i] = Z[(size_t)(r0 + seg * 16 + i) * INC + C_RI + h * 128 + k]; qv[i] = Z[(size_t)(r0 + seg * 16 + i) * INC + C_RQ + h * 128 + k]; }
    {   const GB bf16_t* STp = (const GB bf16_t*)(ws + WS_ST) + (size_t)item * 16384 + (16 * w + fr) * 128 + 8 * g;
#pragma unroll
        for (int kk = 0; kk < 4; ++kk) bs[kk] = *(const GB bf16x8*)(STp + 32 * kk); }
    float loc[16], kr[16], tot[4];
    hg_prep((const GB float*)(ws + WS_RF), (const GB float*)(ws + WS_LB) + layer * DM + h * 128, r0, h, k, seg, segt, loc, kr, tot);
    for (int i = tid; i < 2304; i += 512) ((unsigned*)ATT)[i] = 0u;
    {
        u32x4 w0, w1;
        w0.x = vv[0] | (vv[1] << 16); w0.y = vv[2] | (vv[3] << 16); w0.z = vv[4] | (vv[5] << 16); w0.w = vv[6] | (vv[7] << 16);
        w1.x = vv[8] | (vv[9] << 16); w1.y = vv[10] | (vv[11] << 16); w1.z = vv[12] | (vv[13] << 16); w1.w = vv[14] | (vv[15] << 16);
        *(u32x4*)(VT + k * 144 + seg * 32) = w0; *(u32x4*)(VT + k * 144 + seg * 32 + 16) = w1; }
    float offs = 0.f;
#pragma unroll
    for (int s2 = 0; s2 < 3; ++s2) if (s2 < seg) offs += tot[s2];
    const float eoffs = __expf(offs), lmid = loc[7];
#pragma unroll
    for (int i = 0; i < 16; ++i) {
        const int t = seg * 16 + i;
        const float q = bf2f((bf16_t)qv[i]);
        const float qh = q * __expf(loc[i]);
        *(bf16_t*)(QH + t * 272 + 2 * k) = f2bf1(qh);
        *(bf16_t*)(QT + t * 272 + 2 * k) = f2bf1(qh * eoffs);
        *(bf16_t*)(QD + t * 272 + 2 * k) = f2bf1(q * __expf(fminf(loc[i] - lmid, 80.f)));
        *(bf16_t*)(KD + t * 272 + 2 * k) = f2bf1(kr[i] * __expf(fminf(lmid - loc[i], 80.f)));
        float between = tot[seg] - loc[i];
#pragma unroll
        for (int ti = 1; ti < 4; ++ti) { if (ti > seg) { const int kb = 8 * ti * (ti - 1);
                *(bf16_t*)(KH + (kb + t) * 272 + 2 * k) = f2bf1(kr[i] * __expf(between)); between += tot[ti]; } }
    }
    __syncthreads();
    for (int idx = w; idx < 10; idx += 8) {
        const int ti = idx < 1 ? 0 : idx < 3 ? 1 : idx < 6 ? 2 : 3, si = idx - ti * (ti + 1) / 2;
        const bool diag = ti == si;
        const unsigned char* ab = (diag ? QD : QH) + (16 * ti + fr) * 272 + 16 * g;
        const unsigned char* bb = diag ? KD + (16 * ti + fr) * 272 + 16 * g : KH + (8 * ti * (ti - 1) + 16 * si + fr) * 272 + 16 * g;
        f32x4 acc = {0.f, 0.f, 0.f, 0.f};
#pragma unroll
        for (int kk = 0; kk < 4; ++kk) acc = __builtin_amdgcn_mfma_f32_16x16x32_bf16(*(const bf16x8*)(ab + 64 * kk), *(const bf16x8*)(bb + 64 * kk), acc, 0, 0, 0);
#pragma unroll
        for (int r = 0; r < 4; ++r) { float val = acc[r]; if (diag && fr > 4 * g + r) val = 0.f;
            *(bf16_t*)(ATT + (16 * ti + 4 * g + r) * 144 + (16 * si + fr) * 2) = f2bf1(val); }
    }
    __syncthreads();
    {
        bf16x8 bv[2];
#pragma unroll
        for (int kk = 0; kk < 2; ++kk) bv[kk] = *(const bf16x8*)(VT + (16 * w + fr) * 144 + 16 * g + 64 * kk);
#pragma unroll
        for (int mt = 0; mt < 4; ++mt) {
            f32x4 acc = {0.f, 0.f, 0.f, 0.f};
#pragma unroll
            for (int kk = 0; kk < 4; ++kk) acc = __builtin_amdgcn_mfma_f32_16x16x32_bf16(*(const bf16x8*)(QT + (16 * mt + fr) * 272 + 16 * g + 64 * kk), bs[kk], acc, 0, 0, 0);
#pragma unroll
            for (int kk = 0; kk < 2; ++kk) acc = __builtin_amdgcn_mfma_f32_16x16x32_bf16(*(const bf16x8*)(ATT + (16 * mt + fr) * 144 + 16 * g + 64 * kk), bv[kk], acc, 0, 0, 0);
#pragma unroll
            for (int r = 0; r < 4; ++r) OS[(16 * mt + 4 * g + r) * 132 + 16 * w + fr] = acc[r];
        }
    }
    __syncthreads();
    {   const int t = tid >> 3, vs = (tid & 7) * 16;
        float o[16]; float ss = 0.f;
#pragma unroll
        for (int i = 0; i < 4; ++i) { const f32x4 v = *(const f32x4*)(OS + t * 132 + vs + 4 * i); o[4 * i] = v[0]; o[4 * i + 1] = v[1]; o[4 * i + 2] = v[2]; o[4 * i + 3] = v[3];
            ss += v[0] * v[0] + v[1] * v[1] + v[2] * v[2] + v[3] * v[3]; }
        ss += __shfl_xor(ss, 1); ss += __shfl_xor(ss, 2); ss += __shfl_xor(ss, 4);
        merge_store(P, r0 + t, h * 128 + vs, o, rsqrtf(ss * (1.0f / 128.0f) + EPS), mo);
    }
    __syncthreads();
}

__device__ __forceinline__ void phase_mix(LCTX, const Params& P, int layer, unsigned char* lds) {
    int first = BIDX, stride = GDIM;
    if (EN2 & 4) for (int item = first; item < 2048; item += stride) hgrn_local_item(LARG, P, layer, item, lds);
    asm volatile("" : "+s"(first)); asm volatile("" : "+s"(stride));
    if (EN2 & 1) for (int item = first; item < 512; item += stride) attn_prompt_item(LARG, P, layer, item, lds);
    asm volatile("" : "+s"(first)); asm volatile("" : "+s"(stride));
    if (EN2 & 2) for (int item = first; item < 512; item += stride) attn_sample_item(LARG, P, layer, item, lds);
    asm volatile("" : "+s"(first)); asm volatile("" : "+s"(stride));
    if (EN2 & 8) for (int item = first; item < 1024; item += stride) hgrn_sample_item(LARG, P, layer, item, lds);
}

__device__ __forceinline__ void phase_hout(LCTX, const Params& P, int layer, unsigned char* lds) {
    int first = BIDX, stride = GDIM;
    for (int item = first; item < 2048; item += stride) hgrn_out_item(LARG, P, layer, item, lds);
    asm volatile("" : "+s"(first)); asm volatile("" : "+s"(stride));
    int tid = TIDX; asm volatile("" : "+v"(tid));
    const GB float* OREC = (const GB float*)(uni(P.ws) + WS_OREC);
    const int lane = tid & 63, wave = tid >> 6, c0 = lane * 16;
    for (int row = TP + first * 8 + wave; row < TT; row += stride * 8) {
        float o[16]; float ss = 0.f;
#pragma unroll
        for (int i = 0; i < 4; ++i) { const f32x4 v = *(const GB f32x4*)(OREC + (size_t)row * DM + c0 + 4 * i); o[4 * i] = v[0]; o[4 * i + 1] = v[1]; o[4 * i + 2] = v[2]; o[4 * i + 3] = v[3];
            ss += v[0] * v[0] + v[1] * v[1] + v[2] * v[2] + v[3] * v[3]; }
        ss += __shfl_xor(ss, 1); ss += __shfl_xor(ss, 2); ss += __shfl_xor(ss, 4);
        MergeOps mo; merge_load(P, layer, row, c0, mo);
        merge_store(P, row, c0, o, rsqrtf(ss * (1.0f / 128.0f) + EPS), mo);
    }
}

#ifndef EN2
#define EN2 31
#endif
#ifndef EN
#define EN 511
#endif
#ifndef DUPLO
#define DUPLO 9
#define DUPHI 8
#endif
constexpr int NDUP = (DUPHI >= DUPLO) ? (DUPHI - DUPLO + 1) : 0;
constexpr int NSUB = 9 + NDUP;
constexpr int N_PHASES = 2 + NSUB * NLAYER + 1;

__global__ void __launch_bounds__(NTHREADS, 2) fwd_kernel(Params Parg) {
    extern __shared__ __attribute__((aligned(16))) unsigned char lds[];
    cg::grid_group grid = cg::this_grid();
    const Params* pp0 = (const Params*)__builtin_amdgcn_kernarg_segment_ptr();
    const int ph_lo = Parg.ph_lo, ph_hi = Parg.ph_hi;
    const int wave_s = __builtin_amdgcn_readfirstlane(threadIdx.x >> 6);
    LAS unsigned char* ldsl = (LAS unsigned char*)lds;
    for (int ph = ph_lo; ph < ph_hi; ++ph) {
        const Params* pp = pp0; asm volatile("" : "+s"(pp));
        const Params& P = *pp;
#define ws (uni(P.ws))
        int wv_l = wave_s, bid_l = blockIdx.x, G_l = gridDim.x; asm volatile("" : "+s"(wv_l)); asm volatile("" : "+s"(bid_l)); asm volatile("" : "+s"(G_l));
        const int G = G_l, bid = bid_l;
        if (ph == 0) { if (EN & 1) phase_prologue(LARG, P, lds); }
        else if (ph == 1) {
            pg8::Gemm g{(const bf16_t*)(ws + WS_AC), (const bf16_t*)(ws + WS_WADA), 256, MODLD, DM, DM}; pg8::StaticOrder S; S.init(256, MODLD, G, bid);
            EpiAda E{(GB float*)(ws + WS_MOD), (const GB float*)uni(P.in[I_BADA])};
            if (EN & 2) pg8::gemm_phase<EpiAda, pg8::StaticOrder, true, true>(ldsl, g, S, E, fresh_tid(wv_l));
        } else if (ph == N_PHASES - 1) { if (EN & 4) phase_norm(LARG, P, 0, 2); }
        else {
            const int layer = (ph - 2) / NSUB, si_ = (ph - 2) % NSUB;
            const int sub = (NDUP == 0 || si_ < DUPLO) ? si_ : (si_ < DUPLO + 2 * NDUP ? DUPLO + ((si_ - DUPLO) >> 1) : si_ - NDUP);
            if (sub == 0) { if (EN & 4) phase_norm(LARG, P, layer, 0); }
            else if (sub == 1) {
                pg8::Gemm g{(const bf16_t*)(ws + WS_H), (const bf16_t*)(ws + WS_WIN) + (size_t)layer * INC * DM, TT, INC, DM, DM}; pg8::StaticOrder S; S.init(TT, INC, G, bid);
                EpiIn E{(GB bf16_t*)(ws + WS_Z), (GB float*)(ws + WS_RF), (GB float*)uni(P.out), layer};
                if (EN & 8) pg8::gemm_phase<EpiIn, pg8::StaticOrder, true, true>(ldsl, g, S, E, fresh_tid(wv_l));
            } else if (sub == 2) { if (EN & 16) phase_mix(LARG, P, layer, lds); }
            else if (sub == 3) { if (EN & 32) phase_scan(LARG, P, layer, lds); }
            else if (sub == 4) { if (EN & 32) phase_hout(LARG, P, layer, lds); }
            else if (sub == 5 || sub == 8) {
                const bool dn = sub == 8;
                const float* mod = (const float*)(ws + WS_MOD); float* X = (float*)(ws + WS_X);
                const bf16_t* Ap = dn ? (const bf16_t*)(ws + WS_Z) : (const bf16_t*)(ws + WS_MIX);
                const bf16_t* Bp = dn ? (const bf16_t*)(ws + WS_WDN) + (size_t)layer * DM * DFF : (const bf16_t*)(ws + WS_WOUT) + (size_t)layer * DM * DM;
                const int Kf = dn ? DFF : DM;
                const float* gate = mod + layer * NMOD + (dn ? 5 : 2) * DM;
                {
                    pg8::Gemm g{Ap, Bp, TP, DM, Kf, Kf}; pg8::StaticOrder S; S.init(TP, DM, G, bid);
                    EpiRes E{(const GB float*)((layer == 0 && !dn) ? uni(P.in[I_XP]) : X), (const GB float*)(X + (size_t)TP * DM), (GB float*)X, (const GB float*)gate};
                    if (EN & 64) pg8::gemm_phase<EpiRes, pg8::StaticOrder, true, true>(ldsl, g, S, E, fresh_tid(wv_l));
                }
                {
                    pg8::Gemm g{Ap, Bp, TT, DM, dn ? 1024 : 512, Kf}; SampleSplitOrder S{dn ? 4 : 2, G, bid};
                    EpiPart E{(GB float*)(ws + WS_PART)};
                    if (EN & 64) pg8::gemm_phase<EpiPart, SampleSplitOrder, true, true>(ldsl, g, S, E, fresh_tid(wv_l));
                }
            } else if (sub == 6) { if (EN & 4) phase_norm(LARG, P, layer, 1); }
            else if (sub == 7) {
                pg8::Gemm g{(const bf16_t*)(ws + WS_H), (const bf16_t*)(ws + WS_WUP) + (size_t)layer * DFF * DM, TT, DFF, DM, DM}; pg8::StaticOrder S; S.init(TT, DFF, G, bid);
                EpiUp E{(GB bf16_t*)(ws + WS_Z)};
                if (EN & 128) pg8::gemm_phase<EpiUp, pg8::StaticOrder, true, true>(ldsl, g, S, E, fresh_tid(wv_l));
            }
        }
        if (ph + 1 < ph_hi) { asm volatile("s_waitcnt vmcnt(0) lgkmcnt(0)" ::: "memory"); __syncthreads(); grid.sync(); }
    }
}

#ifndef MULTI_LAUNCH
#define MULTI_LAUNCH 0
#endif

#undef ws
extern "C" void kernel_launch(void* const* d_in, const int* in_sizes, int n_in, void* d_out, int out_size, void* d_ws, size_t ws_size, hipStream_t stream) {
    static int grid_blocks = 0;
    if (grid_blocks == 0) {
        if (n_in != 19 || ws_size < WS_END) { fprintf(stderr, "kernel_launch: need 19 inputs and %zu bytes of workspace; got %d, %zu\n", (size_t)WS_END, n_in, ws_size); grid_blocks = -1; return; }
        int dev = 0, cus = 0, per_cu = 0;
        hipGetDevice(&dev);
        hipDeviceGetAttribute(&cus, hipDeviceAttributeMultiprocessorCount, dev);
        if (hipFuncSetAttribute((const void*)fwd_kernel, hipFuncAttributeMaxDynamicSharedMemorySize, LDS_BYTES) != hipSuccess) { fprintf(stderr, "kernel_launch: hipFuncSetAttribute failed\n"); grid_blocks = -1; return; }
        hipOccupancyMaxActiveBlocksPerMultiprocessor(&per_cu, (const void*)fwd_kernel, NTHREADS, LDS_BYTES);
        if (per_cu < 1) { fprintf(stderr, "kernel_launch: occupancy query says %d blocks per CU\n", per_cu); per_cu = 1; }
        (void)hipGetLastError();
        grid_blocks = cus * 1;
        fprintf(stderr, "kernel_launch: cus %d per_cu %d grid %d\n", cus, per_cu, grid_blocks);
    }
    if (grid_blocks < 0) return;
    Params p{};
    for (int i = 0; i < 19; ++i) p.in[i] = (const float*)d_in[i];
    p.out = (float*)d_out; p.ws = (unsigned char*)d_ws;
#if MULTI_LAUNCH
    for (int ph = 0; ph < N_PHASES; ++ph) { p.ph_lo = ph; p.ph_hi = ph + 1;
        hipLaunchKernelGGL(fwd_kernel, dim3(grid_blocks), dim3(NTHREADS), LDS_BYTES, stream, p); }
#else
    p.ph_lo = 0; p.ph_hi = N_PHASES;
    void* args[] = {&p};
    hipError_t e = hipLaunchCooperativeKernel((const void*)fwd_kernel, dim3(grid_blocks), dim3(NTHREADS), args, LDS_BYTES, stream);
    if (e != hipSuccess) fprintf(stderr, "cooperative launch failed: %s (grid %d)\n", hipGetErrorString(e), grid_blocks);
#endif
}
```

```cpp
#include <hip/hip_runtime.h>
#include <hip/hip_cooperative_groups.h>
#include <cstdio>
#include <cstdint>
namespace cg = cooperative_groups;
namespace pg8 {
#define PG8_LAS __attribute__((address_space(3)))
typedef unsigned short bf16_t;
typedef short bf16x8 __attribute__((ext_vector_type(8)));
typedef float f32x4 __attribute__((ext_vector_type(4)));
typedef unsigned u32x4 __attribute__((ext_vector_type(4)));
constexpr int BM = 256, BK = 64, HALF = 128, HTB = HALF * BK * 2  , STAGE_BYTES = 8 * HTB, NXCD = 8, WGM = 8;

__host__ __device__ __forceinline__ int lds_byte(int r, int c) { const int st = (r >> 4) * 2 + (c >> 5), rr = r & 15, cc = c & 31, ob = rr * 64 + cc * 2; return st * 1024 + (ob ^ (((ob >> 9) & 1) << 5)); }
__host__ __device__ __forceinline__ void stage_rc(int b, int& R, int& C) { const int st = b / 1024, sb = b % 1024, swz = sb ^ (((sb >> 9) & 1) << 5); R = (st >> 1) * 16 + swz / 64; C = (st & 1) * 32 + (swz % 64) / 2; }
__host__ __device__ __forceinline__ int perm32(int rho) { const int n = rho >> 4, i = rho & 15; return 8 * (i >> 2) + 4 * n + (i & 3); }

struct Unit { int pm, pn, ks; };
struct Gemm { const bf16_t* A; const bf16_t* Bt; int M, N, K, ld; };

struct StaticOrder {
    int nM, nN, nwg, G, c;
    __host__ __device__ void init(int M, int N, int G_, int c_) { nM = M / BM; nN = N / BM; nwg = nM * nN; G = G_; c = c_; }
    __host__ __device__ bool next(int i, Unit& u) const {
        const long L = (long)i * G + c; if (L >= nwg) return false;
        int wgid = (int)L; { const int q = nwg / NXCD, r = nwg % NXCD, xcd = wgid % NXCD, off = wgid / NXCD; wgid = (xcd < r ? xcd * (q + 1) : r * (q + 1) + (xcd - r) * q) + off; }
        const int nig = WGM * nN, gid = wgid / nig, fm = gid * WGM, gsz = (nM - fm) < WGM ? (nM - fm) : WGM;
        u.pm = fm + ((wgid % nig) % gsz); u.pn = (wgid % nig) / gsz; u.ks = 0; return true;
    }
    __device__ __forceinline__ void a_ready(const Unit&) const {}
    __device__ __forceinline__ void done(const Unit&) const {}
};

typedef float f32x2_t __attribute__((ext_vector_type(2)));
typedef __bf16 bf16x2_t __attribute__((ext_vector_type(2)));
__device__ __forceinline__ unsigned cvt_pk_bf16(float lo, float hi) { const f32x2_t v = {lo, hi}; const bf16x2_t b = __builtin_convertvector(v, bf16x2_t); return __builtin_bit_cast(unsigned, b); }

template <class Epi, class Sched, bool ALIGN_EPI = false, bool SP2 = false>
__device__ __forceinline__ void gemm_phase(PG8_LAS unsigned char* lds, const Gemm g, const Sched& S, const Epi& E, const int tid) {
    const int wid = __builtin_amdgcn_readfirstlane(tid >> 6), lane = tid & 63, wr = wid >> 2, wc = wid & 3, fr = lane & 15, fq = lane >> 4;
    const int K = g.K, nt = K / BK, LD = g.ld;
    unsigned voffA[2], voffB[2];
#pragma unroll
    for (int i = 0; i < 2; ++i) { int R, C; stage_rc(tid * 16 + i * 8192, R, C); const int Rb = Epi::PERM ? ((R & ~31) + perm32(R & 31)) : R;
        voffA[i] = (unsigned)(R * LD + C) * 2u; voffB[i] = (unsigned)(Rb * LD + C) * 2u; }
    const size_t kstep = (size_t)(BK * 2);
    const size_t hstep = (size_t)HALF * LD * 2;
    const size_t tstep = 2 * hstep;
    const unsigned ldsw = (unsigned)wid * 1024u;
    const int aoff = lds_byte(wr * 64 + fr, fq * 8), boff = lds_byte(wc * 32 + fr, fq * 8);
#define PG8_SA(b, h) (((b) * 2 + (h)) * HTB)
#define PG8_SB(b, h) ((4 + (b) * 2 + (h)) * HTB)
#define PG8_STAGE(bufoff, gbase, voff) do { _Pragma("unroll") for (int _i = 0; _i < 2; ++_i) \
        __builtin_amdgcn_global_load_lds((const unsigned*)((const char*)(gbase) + (voff)[_i]), (PG8_LAS unsigned*)(lds + (bufoff) + ldsw + _i * 8192), 16, 0, 0); } while (0)
#define PG8_LDA(dst, b, h) do { _Pragma("unroll") for (int m = 0; m < 4; ++m) _Pragma("unroll") for (int k = 0; k < 2; ++k) dst[m][k] = *(const PG8_LAS bf16x8*)(lds + PG8_SA(b, h) + aoff + m * 2048 + k * 1024); } while (0)
#define PG8_LDB(dst, b, h) do { _Pragma("unroll") for (int n = 0; n < 2; ++n) _Pragma("unroll") for (int k = 0; k < 2; ++k) dst[n][k] = *(const PG8_LAS bf16x8*)(lds + PG8_SB(b, h) + boff + n * 2048 + k * 1024); } while (0)
#define PG8_MMA(ai, bj, At, Bt) do { __builtin_amdgcn_s_setprio(1); _Pragma("unroll") for (int m = 0; m < 4; ++m) _Pragma("unroll") for (int n = 0; n < 2; ++n) _Pragma("unroll") for (int k = 0; k < 2; ++k) \
        acc[ai][bj][m][n] = __builtin_amdgcn_mfma_f32_16x16x32_bf16(Bt[n][k], At[m][k], acc[ai][bj][m][n], 0, 0, 0); __builtin_amdgcn_s_setprio(0); } while (0)
#define PG8_WAIT_V(n) asm volatile("s_waitcnt vmcnt(" #n ")" ::: "memory")
#define PG8_WAIT_L(n) asm volatile("s_waitcnt lgkmcnt(" #n ")" ::: "memory")
#define PG8_BAR __builtin_amdgcn_s_barrier()
#define PG8_SCHED __builtin_amdgcn_sched_barrier(0)
    Unit cur, nxt; int ui = 0;
    if (!S.next(0, cur)) return;
    f32x4 acc[2][2][4][2];
#pragma unroll
    for (int a = 0; a < 2; ++a)
#pragma unroll
        for (int b = 0; b < 2; ++b)
#pragma unroll
            for (int m = 0; m < 4; ++m)
#pragma unroll
                for (int n = 0; n < 2; ++n) acc[a][b][m][n] = (f32x4){0.f, 0.f, 0.f, 0.f};
    bf16x8 At[4][2], B0[2][2], B1[2][2];
    const size_t kspl = (size_t)K * 2;
    const char* cA = (const char*)g.A + (size_t)cur.pm * tstep + (size_t)cur.ks * kspl; const char* cB = (const char*)g.Bt + (size_t)cur.pn * tstep + (size_t)cur.ks * kspl;
    S.a_ready(cur);
    if constexpr (SP2) {
        PG8_STAGE(PG8_SB(0, 0), cB, voffB); PG8_STAGE(PG8_SB(0, 1), cB + hstep, voffB); PG8_STAGE(PG8_SA(0, 0), cA, voffA); PG8_STAGE(PG8_SA(0, 1), cA + hstep, voffA);
        if (wr == 1) PG8_BAR;
        PG8_WAIT_V(2); PG8_BAR;
        PG8_STAGE(PG8_SB(1, 0), cB + kstep, voffB); PG8_STAGE(PG8_SA(1, 0), cA + kstep, voffA); PG8_STAGE(PG8_SB(1, 1), cB + hstep + kstep, voffB);
        PG8_WAIT_V(6); PG8_BAR;
    } else {
        PG8_STAGE(PG8_SB(0, 0), cB, voffB); PG8_STAGE(PG8_SA(0, 0), cA, voffA); PG8_STAGE(PG8_SB(0, 1), cB + hstep, voffB); PG8_STAGE(PG8_SA(0, 1), cA + hstep, voffA);
        if (wr == 1) PG8_BAR;
        PG8_WAIT_V(4); PG8_BAR;
        PG8_STAGE(PG8_SB(1, 0), cB + kstep, voffB); PG8_STAGE(PG8_SA(1, 0), cA + kstep, voffA); PG8_STAGE(PG8_SB(1, 1), cB + hstep + kstep, voffB);
        PG8_WAIT_V(6); PG8_BAR;
    }
    for (;;) {
        const bool has_next = S.next(ui + 1, nxt);
        const char* nA = has_next ? (const char*)g.A + (size_t)nxt.pm * tstep + (size_t)nxt.ks * kspl : cA; const char* nB = has_next ? (const char*)g.Bt + (size_t)nxt.pn * tstep + (size_t)nxt.ks * kspl : cB;
        for (int t = 0; t < nt; t += 2) {
            const bool last = (t == nt - 2);
            const char* a1 = cA + (size_t)(t + 1) * kstep;
            const char* a2 = last ? nA : cA + (size_t)(t + 2) * kstep; const char* b2 = last ? nB : cB + (size_t)(t + 2) * kstep;
            const char* a3 = a2 + kstep; const char* b3 = b2 + kstep;
            if (last && has_next) S.a_ready(nxt);
            if constexpr (SP2) {
            PG8_LDB(B0, 0, 0); PG8_LDB(B1, 0, 1); PG8_SCHED; PG8_LDA(At, 0, 0); PG8_STAGE(PG8_SA(1, 1), a1 + hstep, voffA);
            PG8_WAIT_V(8); PG8_WAIT_L(0); PG8_BAR; PG8_MMA(0, 0, At, B0); PG8_MMA(0, 1, At, B1); PG8_BAR; PG8_SCHED;
            PG8_LDA(At, 0, 1); PG8_STAGE(PG8_SB(0, 0), b2, voffB); PG8_STAGE(PG8_SB(0, 1), b2 + hstep, voffB); PG8_STAGE(PG8_SA(0, 0), a2, voffA);
            PG8_WAIT_V(8); PG8_WAIT_L(0); PG8_BAR; PG8_MMA(1, 0, At, B0); PG8_MMA(1, 1, At, B1); PG8_BAR; PG8_SCHED;
            PG8_LDB(B0, 1, 0); PG8_LDB(B1, 1, 1); PG8_SCHED; PG8_LDA(At, 1, 0); PG8_STAGE(PG8_SA(0, 1), a2 + hstep, voffA);
            PG8_WAIT_V(8); PG8_WAIT_L(0); PG8_BAR; PG8_MMA(0, 0, At, B0); PG8_MMA(0, 1, At, B1); PG8_BAR; PG8_SCHED;
            PG8_LDA(At, 1, 1); PG8_STAGE(PG8_SB(1, 0), b3, voffB); PG8_STAGE(PG8_SB(1, 1), b3 + hstep, voffB); PG8_STAGE(PG8_SA(1, 0), a3, voffA);
            PG8_WAIT_V(8); PG8_WAIT_L(0); PG8_BAR; PG8_MMA(1, 0, At, B0); PG8_MMA(1, 1, At, B1); PG8_BAR; PG8_SCHED;
            } else {
            PG8_LDB(B0, 0, 0); PG8_SCHED; PG8_LDA(At, 0, 0); PG8_STAGE(PG8_SA(1, 1), a1 + hstep, voffA);
            PG8_WAIT_L(8); PG8_BAR; PG8_WAIT_L(0); PG8_MMA(0, 0, At, B0); PG8_BAR; PG8_SCHED;
            PG8_LDB(B1, 0, 1); PG8_STAGE(PG8_SB(0, 0), b2, voffB);
            PG8_BAR; PG8_WAIT_L(0); PG8_MMA(0, 1, At, B1); PG8_BAR;
            PG8_LDA(At, 0, 1); PG8_STAGE(PG8_SA(0, 0), a2, voffA);
            PG8_BAR; PG8_WAIT_L(0); PG8_MMA(1, 0, At, B0); PG8_BAR; PG8_SCHED;
            PG8_STAGE(PG8_SB(0, 1), b2 + hstep, voffB);
            PG8_WAIT_V(6); PG8_BAR; PG8_MMA(1, 1, At, B1); PG8_BAR;
            PG8_LDB(B0, 1, 0); PG8_SCHED; PG8_LDA(At, 1, 0); PG8_STAGE(PG8_SA(0, 1), a2 + hstep, voffA);
            PG8_WAIT_L(8); PG8_BAR; PG8_WAIT_L(0); PG8_MMA(0, 0, At, B0); PG8_BAR; PG8_SCHED;
            PG8_LDB(B1, 1, 1); PG8_STAGE(PG8_SB(1, 0), b3, voffB);
            PG8_BAR; PG8_WAIT_L(0); PG8_MMA(0, 1, At, B1); PG8_BAR;
            PG8_LDA(At, 1, 1); PG8_STAGE(PG8_SA(1, 0), a3, voffA);
            PG8_BAR; PG8_WAIT_L(0); PG8_MMA(1, 0, At, B0); PG8_BAR; PG8_SCHED;
            PG8_STAGE(PG8_SB(1, 1), b3 + hstep, voffB);
            PG8_WAIT_V(6); PG8_BAR; PG8_MMA(1, 1, At, B1); PG8_BAR;
            }
        }
        if constexpr (ALIGN_EPI) { if (wr == 0) PG8_BAR; }
        if constexpr (!Epi::AFTER_DRAIN) { E(acc, cur, wr, wc, fr, fq); S.done(cur); }
        if (!has_next) break;
#pragma unroll
        for (int a = 0; a < 2; ++a)
#pragma unroll
            for (int b = 0; b < 2; ++b)
#pragma unroll
                for (int m = 0; m < 4; ++m)
#pragma unroll
                    for (int n = 0; n < 2; ++n) acc[a][b][m][n] = (f32x4){0.f, 0.f, 0.f, 0.f};
        cur = nxt; cA = nA; cB = nB; ++ui;
        if constexpr (ALIGN_EPI) { if (wr == 1) PG8_BAR; }
    }
    PG8_WAIT_V(0);
    if constexpr (!ALIGN_EPI) { if (wr == 0) PG8_BAR; }
    PG8_BAR;
    if constexpr (Epi::AFTER_DRAIN) { E.fused(acc, cur, wr, wc, fr, fq, lds, wid, lane); S.done(cur); }
#undef PG8_SA
#undef PG8_SB
#undef PG8_STAGE
#undef PG8_LDA
#undef PG8_LDB
#undef PG8_MMA
#undef PG8_WAIT_V
#undef PG8_WAIT_L
#undef PG8_BAR
#undef PG8_SCHED
}
}

#define LAS __attribute__((address_space(3)))
#define GB __attribute__((address_space(1)))
#ifndef EN2
#define EN2 31
#endif
#define TIDX fresh_tid(wv_l)
#define BIDX bid_l
#define GDIM G_l
#define LCTX const int wv_l, const int bid_l, const int G_l
#define LARG wv_l, bid_l, G_l
typedef unsigned short bf16_t;
typedef short bf16x8 __attribute__((ext_vector_type(8)));
typedef short s16x4 __attribute__((ext_vector_type(4)));
typedef float f32x4 __attribute__((ext_vector_type(4)));
typedef unsigned u32x4 __attribute__((ext_vector_type(4)));
typedef unsigned u32x2 __attribute__((ext_vector_type(2)));
using pg8::cvt_pk_bf16;

constexpr int DM = 1024, TP = 16384, TS = 1024, TT = TP + TS;
constexpr int NLAYER = 4, INC = 7680, DFF = 4096, NMOD = 6144, MODLD = 4 * NMOD;
constexpr int C_Q = 0, C_K = 1024, C_V = 1280, C_RQ = 1536, C_RF = 2560, C_RI = 3584, C_RG = 4608, C_GA = 5632, C_GR = 6656;
constexpr float EPS = 1e-6f;
constexpr int NTHREADS = 512;
constexpr int LDS_BYTES = 147456;

constexpr size_t O_YP = 0, O_YS = 16777216, O_WKP = 17825792, O_WVP = 18350080, O_HP = 18874368, O_WKS = 20971520, O_WVS = 37748736, O_HS = 54525952;

constexpr size_t al256(size_t x) { return (x + 255) & ~(size_t)255; }
constexpr size_t WS_WIN = 0;
constexpr size_t WS_WOUT = WS_WIN + (size_t)NLAYER * INC * DM * 2;
constexpr size_t WS_WUP = WS_WOUT + (size_t)NLAYER * DM * DM * 2;
constexpr size_t WS_WDN = WS_WUP + (size_t)NLAYER * DFF * DM * 2;
constexpr size_t WS_WADA = WS_WDN + (size_t)NLAYER * DM * DFF * 2;
constexpr size_t WS_AC = WS_WADA + (size_t)NLAYER * NMOD * DM * 2;
constexpr size_t WS_MOD = WS_AC + (size_t)256 * DM * 2;
constexpr size_t WS_LB = WS_MOD + (size_t)256 * MODLD * 4;
constexpr size_t WS_X = WS_LB + (size_t)NLAYER * DM * 4;
constexpr size_t WS_H = WS_X + (size_t)TT * DM * 4;
constexpr size_t WS_MIX = WS_H + (size_t)TT * DM * 2;
constexpr size_t WS_OATT = WS_MIX + (size_t)TT * DM * 2;
constexpr size_t WS_RF = WS_OATT + (size_t)TT * DM * 2;
constexpr size_t WS_OREC = WS_RF + (size_t)TT * DM * 4;
constexpr size_t WS_Z = WS_OREC + (size_t)TT * DM * 4;
constexpr size_t WS_UT = WS_Z + (size_t)TT * INC * 2;
constexpr size_t WS_ST = WS_UT + (size_t)2048 * 16384 * 2;
constexpr size_t WS_DC = WS_ST + (size_t)2048 * 16384 * 2;
constexpr size_t WS_PART = WS_DC + (size_t)2048 * 128 * 4;
constexpr size_t WS_END = WS_PART + (size_t)4 * TS * DM * 4;

struct Params { const float* in[19]; float* out; unsigned char* ws; int ph_lo, ph_hi; };

enum { I_XP = 0, I_XS, I_CK, I_CV, I_ST, I_CP, I_CS, I_NMIX, I_NMLP, I_WADA, I_BADA, I_WIN, I_SINK, I_LBL, I_HNORM, I_WOUT, I_WUP, I_WDN, I_FNORM };

__device__ __forceinline__ int fresh_tid(int wave_s) { int l; asm volatile("v_mbcnt_lo_u32_b32 %0, -1, 0\n\tv_mbcnt_hi_u32_b32 %0, -1, %0" : "=v"(l)); return wave_s * 64 + l; }
template <class T> __device__ __forceinline__ T* uni(T* p) { const unsigned long long v = (unsigned long long)p; const unsigned lo = __builtin_amdgcn_readfirstlane((unsigned)v), hi = __builtin_amdgcn_readfirstlane((unsigned)(v >> 32)); return (T*)(((unsigned long long)hi << 32) | lo); }
__device__ __forceinline__ float bf2f(bf16_t b) { return __uint_as_float((unsigned)b << 16); }
__device__ __forceinline__ float sigmoidf_(float x) { return __builtin_amdgcn_rcpf(1.0f + __expf(-x)); }
__device__ __forceinline__ float siluf_(float x) { return x * sigmoidf_(x); }
__device__ __forceinline__ int mod_row(int row) { return row < TP ? 128 + (row >> 12) : (row - TP) >> 3; }
__device__ __forceinline__ u32x2 pack4(f32x4 v) { u32x2 r; r.x = cvt_pk_bf16(v[0], v[1]); r.y = cvt_pk_bf16(v[2], v[3]); return r; }

#define EPI_ROWS  _Pragma("unroll") for (int ai = 0; ai < 2; ++ai) _Pragma("unroll") for (int m = 0; m < 4; ++m)
#define EPI_COLS  _Pragma("unroll") for (int bj = 0; bj < 2; ++bj) _Pragma("unroll") for (int n = 0; n < 2; ++n)

struct EpiAda {
    static constexpr bool PERM = true, AFTER_DRAIN = false;
    GB float* mod; const GB float* bias;
    __device__ __forceinline__ void operator()(const f32x4 (&acc)[2][2][4][2], const pg8::Unit& u, int wr, int wc, int fr, int fq) const {
        const int col0 = u.pn * 256 + wc * 32 + 8 * fq;
        EPI_ROWS { const int row = u.pm * 256 + ai * 128 + wr * 64 + m * 16 + fr;
#pragma unroll
            for (int bj = 0; bj < 2; ++bj) { const int col = col0 + bj * 128; GB float* d = mod + (size_t)row * MODLD + col;
                *(GB f32x4*)d = acc[ai][bj][m][0] + *(const GB f32x4*)(bias + col); *(GB f32x4*)(d + 4) = acc[ai][bj][m][1] + *(const GB f32x4*)(bias + col + 4); } }
    }
};

struct EpiIn {
    static constexpr bool PERM = true, AFTER_DRAIN = false;
    GB bf16_t* Z; GB float* RF; GB float* out; int layer;
    __device__ __forceinline__ void operator()(const f32x4 (&acc)[2][2][4][2], const pg8::Unit& u, int wr, int wc, int fr, int fq) const {
        const int cb = u.pn * 256;
        const int row0 = u.pm * 256 + wr * 64 + fr, col0 = cb + wc * 32 + 8 * fq;
        if (cb >= C_RF && cb < C_RI) {
            GB float* dst = RF + (size_t)row0 * DM + (col0 - C_RF);
            EPI_ROWS {
#pragma unroll
                for (int bj = 0; bj < 2; ++bj) { GB float* d = dst + (size_t)(ai * 128 + m * 16) * DM + bj * 128;
                    *(GB f32x4*)d = acc[ai][bj][m][0]; *(GB f32x4*)(d + 4) = acc[ai][bj][m][1]; } }
        } else if (cb >= C_K && cb < C_RQ) {
            GB bf16_t* dst = Z + (size_t)row0 * INC + col0;
            const int kv = (cb >= C_V) ? 1 : 0, cc0 = col0 - C_K - 256 * kv;
            EPI_ROWS { const int row = row0 + ai * 128 + m * 16;
                GB float* wdst = nullptr;
                if (row >= TP) { const int sr = row - TP; wdst = out + (kv ? O_WVS : O_WKS) + ((size_t)((layer * 128 + (sr >> 3)) * 128 + 120 + (sr & 7))) * 256 + cc0; }
                else if ((row & 4095) >= 3968) wdst = out + (kv ? O_WVP : O_WKP) + ((size_t)((layer * 4 + (row >> 12)) * 128 + ((row & 4095) - 3968))) * 256 + cc0;
#pragma unroll
                for (int bj = 0; bj < 2; ++bj) { const f32x4 v0 = acc[ai][bj][m][0], v1 = acc[ai][bj][m][1];
                    const u32x2 p0 = pack4(v0), p1 = pack4(v1); u32x4 w; w.x = p0.x; w.y = p0.y; w.z = p1.x; w.w = p1.y;
                    *(GB u32x4*)(dst + (size_t)(ai * 128 + m * 16) * INC + bj * 128) = w;
                    if (wdst) { *(GB f32x4*)(wdst + bj * 128) = v0; *(GB f32x4*)(wdst + bj * 128 + 4) = v1; } } }
        } else {
            int mode = 0;
            if (cb >= C_RQ && cb < C_RF) mode = 2; else if (cb >= C_RG && cb < C_GA) mode = 4; else if (cb >= C_GA) mode = 5;
            GB bf16_t* dst = Z + (size_t)row0 * INC + col0;
            EPI_ROWS {
#pragma unroll
                for (int bj = 0; bj < 2; ++bj) { f32x4 v0 = acc[ai][bj][m][0], v1 = acc[ai][bj][m][1];
                    if (mode != 0) {
#pragma unroll
                        for (int q = 0; q < 4; ++q) { const float s0 = sigmoidf_(v0[q]), s1 = sigmoidf_(v1[q]);
                            v0[q] = mode == 5 ? s0 : (mode == 4 ? v0[q] * s0 : v0[q] * s0 * 0.08838834764831845f);
                            v1[q] = mode == 5 ? s1 : (mode == 4 ? v1[q] * s1 : v1[q] * s1 * 0.08838834764831845f); } }
                    const u32x2 p0 = pack4(v0), p1 = pack4(v1); u32x4 w; w.x = p0.x; w.y = p0.y; w.z = p1.x; w.w = p1.y;
                    *(GB u32x4*)(dst + (size_t)(ai * 128 + m * 16) * INC + bj * 128) = w; } }
        }
    }
};

struct EpiRes {
    static constexpr bool PERM = true, AFTER_DRAIN = false;
    const GB float* xp; const GB float* xs; GB float* X; const GB float* gate;
    __device__ __forceinline__ void operator()(const f32x4 (&acc)[2][2][4][2], const pg8::Unit& u, int wr, int wc, int fr, int fq) const {
        const int col0 = u.pn * 256 + wc * 32 + 8 * fq;
        const GB float* gr = gate + (size_t)(128 + (u.pm >> 4)) * MODLD + col0;
        f32x4 g[2][2];
#pragma unroll
        for (int bj = 0; bj < 2; ++bj) { g[bj][0] = *(const GB f32x4*)(gr + bj * 128); g[bj][1] = *(const GB f32x4*)(gr + bj * 128 + 4); }
        EPI_ROWS { const int row = u.pm * 256 + ai * 128 + wr * 64 + m * 16 + fr;
            const GB float* xr = xp + (size_t)row * DM + col0;
            GB float* d = X + (size_t)row * DM + col0;
#pragma unroll
            for (int bj = 0; bj < 2; ++bj) {
                const f32x4 xo0 = *(const GB f32x4*)(xr + bj * 128), xo1 = *(const GB f32x4*)(xr + bj * 128 + 4);
                *(GB f32x4*)(d + bj * 128) = xo0 + g[bj][0] * acc[ai][bj][m][0]; *(GB f32x4*)(d + bj * 128 + 4) = xo1 + g[bj][1] * acc[ai][bj][m][1]; } }
    }
};

struct EpiPart {
    static constexpr bool PERM = true, AFTER_DRAIN = false;
    GB float* part;
    __device__ __forceinline__ void operator()(const f32x4 (&acc)[2][2][4][2], const pg8::Unit& u, int wr, int wc, int fr, int fq) const {
        GB float* dst = part + ((size_t)u.ks * TS + (size_t)(u.pm * 256 - TP + wr * 64 + fr)) * DM + u.pn * 256 + wc * 32 + 8 * fq;
        EPI_ROWS {
#pragma unroll
            for (int bj = 0; bj < 2; ++bj) { GB float* d = dst + (size_t)(ai * 128 + m * 16) * DM + bj * 128; *(GB f32x4*)d = acc[ai][bj][m][0]; *(GB f32x4*)(d + 4) = acc[ai][bj][m][1]; } }
    }
};
struct SampleSplitOrder {
    int nsplit, G, c;
    __device__ bool next(int i, pg8::Unit& u) const { const int L = i * G + c; if (L >= 16 * nsplit) return false;
        const int t = L / nsplit; u.ks = L - t * nsplit; u.pm = 64 + (t >> 2); u.pn = t & 3; return true; }
    __device__ __forceinline__ void a_ready(const pg8::Unit&) const {}
    __device__ __forceinline__ void done(const pg8::Unit&) const {}
};

struct EpiUp {
    static constexpr bool PERM = true, AFTER_DRAIN = false;
    GB bf16_t* U;
    __device__ __forceinline__ void operator()(const f32x4 (&acc)[2][2][4][2], const pg8::Unit& u, int wr, int wc, int fr, int fq) const {
        GB bf16_t* dst = U + (size_t)(u.pm * 256 + wr * 64 + fr) * DFF + u.pn * 256 + wc * 32 + 8 * fq;
        EPI_ROWS {
#pragma unroll
            for (int bj = 0; bj < 2; ++bj) { f32x4 v0 = acc[ai][bj][m][0], v1 = acc[ai][bj][m][1];
#pragma unroll
                for (int j = 0; j < 4; ++j) { const float r0 = fmaxf(v0[j], 0.f), r1 = fmaxf(v1[j], 0.f); v0[j] = r0 * r0; v1[j] = r1 * r1; }
                const u32x2 p0 = pack4(v0), p1 = pack4(v1); u32x4 w; w.x = p0.x; w.y = p0.y; w.z = p1.x; w.w = p1.y;
                *(GB u32x4*)(dst + (size_t)(ai * 128 + m * 16) * DFF + bj * 128) = w; } }
    }
};

__device__ __forceinline__ void transpose_tile4(LCTX, const float* __restrict__ W, int K, int N, bf16_t* __restrict__ Wt, int tk, int tn0, float* tile) {
    const int tid = TIDX;
    f32x4 v[4][2];
#pragma unroll
    for (int q = 0; q < 4; ++q)
#pragma unroll
        for (int i = 0; i < 2; ++i) { const int idx = tid + i * 512, r = idx >> 4, c4 = (idx & 15) * 4;
            v[q][i] = *(const f32x4*)(W + (size_t)(tk * 64 + r) * N + (tn0 + q) * 64 + c4); }
#pragma unroll
    for (int q = 0; q < 4; ++q)
#pragma unroll
        for (int i = 0; i < 2; ++i) { const int idx = tid + i * 512, r = idx >> 4, c4 = (idx & 15) * 4; float* t_ = tile + q * 4160;
            t_[r * 65 + c4 + 0] = v[q][i][0]; t_[r * 65 + c4 + 1] = v[q][i][1]; t_[r * 65 + c4 + 2] = v[q][i][2]; t_[r * 65 + c4 + 3] = v[q][i][3]; }
    __syncthreads();
    const int n = tid >> 3, k8 = (tid & 7) * 8;
#pragma unroll
    for (int q = 0; q < 4; ++q) { const float* t_ = tile + q * 4160;
        u32x4 w;
        w.x = cvt_pk_bf16(t_[(k8 + 0) * 65 + n], t_[(k8 + 1) * 65 + n]); w.y = cvt_pk_bf16(t_[(k8 + 2) * 65 + n], t_[(k8 + 3) * 65 + n]);
        w.z = cvt_pk_bf16(t_[(k8 + 4) * 65 + n], t_[(k8 + 5) * 65 + n]); w.w = cvt_pk_bf16(t_[(k8 + 6) * 65 + n], t_[(k8 + 7) * 65 + n]);
        *(u32x4*)(Wt + (size_t)((tn0 + q) * 64 + n) * K + tk * 64 + k8) = w; }
    __syncthreads();
}

__device__ __forceinline__ void phase_prologue(LCTX, const Params& P, unsigned char* lds) {
    unsigned char* ws = uni(P.ws);
    float* tile = (float*)lds;
    constexpr int N_IN = 16 * 120, N_OUT = 16 * 16, N_UP = 16 * 64, N_DN = 64 * 16, N_ADA = 16 * 96, PER_L = N_IN + N_OUT + N_UP + N_DN + N_ADA;
    for (int item = 4 * BIDX; item < NLAYER * PER_L; item += 4 * GDIM) {
        const int l = item / PER_L; int r = item % PER_L;
        if (r < N_IN) { transpose_tile4(LARG, uni(P.in[I_WIN]) + (size_t)l * DM * INC, DM, INC, (bf16_t*)(ws + WS_WIN) + (size_t)l * INC * DM, r / 120, r % 120, tile); continue; }
        r -= N_IN;
        if (r < N_OUT) { transpose_tile4(LARG, uni(P.in[I_WOUT]) + (size_t)l * DM * DM, DM, DM, (bf16_t*)(ws + WS_WOUT) + (size_t)l * DM * DM, r / 16, r % 16, tile); continue; }
        r -= N_OUT;
        if (r < N_UP) { transpose_tile4(LARG, uni(P.in[I_WUP]) + (size_t)l * DM * DFF, DM, DFF, (bf16_t*)(ws + WS_WUP) + (size_t)l * DFF * DM, r / 64, r % 64, tile); continue; }
        r -= N_UP;
        if (r < N_DN) { transpose_tile4(LARG, uni(P.in[I_WDN]) + (size_t)l * DFF * DM, DFF, DM, (bf16_t*)(ws + WS_WDN) + (size_t)l * DM * DFF, r / 16, r % 16, tile); continue; }
        r -= N_DN;
        transpose_tile4(LARG, uni(P.in[I_WADA]) + (size_t)l * DM * NMOD, DM, NMOD, (bf16_t*)(ws + WS_WADA) + (size_t)l * NMOD * DM, r / 96, r % 96, tile);
    }
    bf16_t* AC = (bf16_t*)(ws + WS_AC);
    for (int idx = BIDX * NTHREADS + TIDX; idx < 256 * DM / 4; idx += GDIM * NTHREADS) {
        const int row = idx >> 8, c4 = (idx & 255) * 4;
        f32x4 v = {0.f, 0.f, 0.f, 0.f};
        if (row < 128) v = *(const f32x4*)(uni(P.in[I_CS]) + (size_t)row * DM + c4);
        else if (row < 132) v = *(const f32x4*)(uni(P.in[I_CP]) + (size_t)(row - 128) * DM + c4);
        v[0] = siluf_(v[0]); v[1] = siluf_(v[1]); v[2] = siluf_(v[2]); v[3] = siluf_(v[3]);
        *(u32x2*)(AC + (size_t)row * DM + c4) = pack4(v);
    }
    float* LB = (float*)(ws + WS_LB);
    for (int ch = BIDX * NTHREADS + TIDX; ch < DM; ch += GDIM * NTHREADS) {
        const float* lg = uni(P.in[I_LBL]);
        const float a0 = lg[ch], a1 = lg[DM + ch], a2 = lg[2 * DM + ch], a3 = lg[3 * DM + ch];
        const float mx = fmaxf(fmaxf(a0, a1), fmaxf(a2, a3));
        const float e0 = __expf(a0 - mx), e1 = __expf(a1 - mx), e2 = __expf(a2 - mx), e3 = __expf(a3 - mx);
        const float inv = 1.0f / (e0 + e1 + e2 + e3);
        LB[ch] = 0.f; LB[DM + ch] = e1 * inv; LB[2 * DM + ch] = (e1 + e2) * inv; LB[3 * DM + ch] = (e1 + e2 + e3) * inv;
    }
}

__device__ __forceinline__ void phase_norm(LCTX, const Params& P, int layer, int which) {
    unsigned char* ws = uni(P.ws);
    const int tid = TIDX; const int lane = tid & 63, wave = tid >> 6;
    const float* X = (const float*)(ws + WS_X);
    const float* mod = (const float*)(ws + WS_MOD);
    bf16_t* H = (bf16_t*)(ws + WS_H);
    const float* gw = which == 0 ? uni(P.in[I_NMIX]) + layer * DM : which == 1 ? uni(P.in[I_NMLP]) + layer * DM : uni(P.in[I_FNORM]);
    for (int row = BIDX * 8 + wave; row < TT; row += GDIM * 8) {
        const float* xr = (layer == 0 && which == 0) ? (row < TP ? uni(P.in[I_XP]) + (size_t)row * DM : uni(P.in[I_XS]) + (size_t)(row - TP) * DM) : X + (size_t)row * DM;
        f32x4 v[4]; float ss = 0.f;
#pragma unroll
        for (int i = 0; i < 4; ++i) v[i] = *(const f32x4*)(xr + i * 256 + lane * 4);
        if (row >= TP && !(layer == 0 && which == 0)) {
            const int nsl = which == 1 ? 2 : 4, gl = which == 1 ? layer : (which == 2 ? NLAYER - 1 : layer - 1);
            const float* gp = mod + (size_t)mod_row(row) * MODLD + gl * NMOD + (which == 1 ? 2 : 5) * DM;
            const float* pp_ = (const float*)(ws + WS_PART) + (size_t)(row - TP) * DM;
#pragma unroll
            for (int i = 0; i < 4; ++i) { const int c = i * 256 + lane * 4; f32x4 a = *(const f32x4*)(pp_ + c);
                for (int s2 = 1; s2 < nsl; ++s2) a += *(const f32x4*)(pp_ + (size_t)s2 * TS * DM + c);
                v[i] += *(const f32x4*)(gp + c) * a;
                *(f32x4*)((float*)(ws + WS_X) + (size_t)row * DM + c) = v[i]; }
        }
#pragma unroll
        for (int i = 0; i < 4; ++i) { ss += v[i][0] * v[i][0] + v[i][1] * v[i][1] + v[i][2] * v[i][2] + v[i][3] * v[i][3]; }
#pragma unroll
        for (int o = 1; o < 64; o <<= 1) ss += __shfl_xor(ss, o);
        const float r = rsqrtf(ss * (1.0f / DM) + EPS);
        if (layer == 0 && which == 0 && row >= TP) {
#pragma unroll
            for (int i = 0; i < 4; ++i) *(f32x4*)((float*)(ws + WS_X) + (size_t)row * DM + i * 256 + lane * 4) = v[i]; }
        if (which == 2) {
#pragma unroll
            for (int i = 0; i < 4; ++i) { const int c = i * 256 + lane * 4; const f32x4 g = *(const f32x4*)(gw + c);
                *(f32x4*)(uni(P.out) + (size_t)row * DM + c) = v[i] * r * g; }
        } else {
            const float* mr = mod + (size_t)mod_row(row) * MODLD + layer * NMOD + (which ? 3 : 0) * DM;
#pragma unroll
            for (int i = 0; i < 4; ++i) { const int c = i * 256 + lane * 4; const f32x4 g = *(const f32x4*)(gw + c);
                const f32x4 sh = *(const f32x4*)(mr + c), sc = *(const f32x4*)(mr + DM + c);
                const f32x4 h = (v[i] * r * g) * (sc + 1.0f) + sh;
                *(u32x2*)(H + (size_t)row * DM + c) = pack4(h); }
        }
    }
}

struct KLdsLoader { const unsigned char* ks; int fr, g, kbase;
    __device__ __forceinline__ bf16x8 get(int kt, int kk) const { return *(const bf16x8*)(ks + (kbase + 16 * kt + fr) * 144 + (g * 8 + 32 * kk) * 2); } };
struct VLdsLoader { const unsigned char* vt; int fr, g, kbase;
    __device__ __forceinline__ bf16x8 get(int dt, int c) const {
        const int d_ = 16 * dt + fr;
        const unsigned char* p = vt + d_ * 528 + (((kbase + 32 * c + 4 * g) ^ (((d_ >> 3) & 7) << 2))) * 2;
        const unsigned char* p2 = vt + d_ * 528 + (((kbase + 32 * c + 16 + 4 * g) ^ (((d_ >> 3) & 7) << 2))) * 2;
        const s16x4 a = *(const s16x4*)p, b = *(const s16x4*)p2;
        bf16x8 r; r[0] = a[0]; r[1] = a[1]; r[2] = a[2]; r[3] = a[3]; r[4] = b[0]; r[5] = b[1]; r[6] = b[2]; r[7] = b[3]; return r; } };
template <class KL, class VL>
__device__ __forceinline__ void attn_task(const KL& kl, const VL& vl, const bf16x8 qf0, const bf16x8 qf1, int iq, float slope, float sink, int kbase, int dmax, bf16_t* orow, int g) {
    f32x4 s[10];
#pragma unroll
    for (int kt = 0; kt < 10; ++kt) { const bf16x8 k0 = kl.get(kt, 0), k1 = kl.get(kt, 1);
        f32x4 a = {0.f, 0.f, 0.f, 0.f};
        a = __builtin_amdgcn_mfma_f32_16x16x32_bf16(k0, qf0, a, 0, 0, 0);
        a = __builtin_amdgcn_mfma_f32_16x16x32_bf16(k1, qf1, a, 0, 0, 0); s[kt] = a; }
    float mx = sink;
    const int dbase = iq + 128 - kbase - 4 * g;
#pragma unroll
    for (int kt = 0; kt < 10; ++kt)
#pragma unroll
        for (int r = 0; r < 4; ++r) { const int dist = dbase - 16 * kt - r;
            const float v = ((unsigned)dist <= (unsigned)dmax) ? s[kt][r] * 0.125f - slope * (float)dist : -1e30f;
            s[kt][r] = v; mx = fmaxf(mx, v); }
    mx = fmaxf(mx, __shfl_xor(mx, 16)); mx = fmaxf(mx, __shfl_xor(mx, 32));
    float l = 0.f;
#pragma unroll
    for (int kt = 0; kt < 10; ++kt)
#pragma unroll
        for (int r = 0; r < 4; ++r) { const float p = __expf(s[kt][r] - mx); s[kt][r] = p; l += p; }
    l += __shfl_xor(l, 16); l += __shfl_xor(l, 32);
    l += __expf(sink - mx);
    const float inv = 1.0f / l;
    f32x4 o[4];
#pragma unroll
    for (int dt = 0; dt < 4; ++dt) o[dt] = (f32x4){0.f, 0.f, 0.f, 0.f};
#pragma unroll
    for (int c = 0; c < 5; ++c) {
        const unsigned w0 = cvt_pk_bf16(s[2 * c][0], s[2 * c][1]), w1 = cvt_pk_bf16(s[2 * c][2], s[2 * c][3]);
        const unsigned w2 = cvt_pk_bf16(s[2 * c + 1][0], s[2 * c + 1][1]), w3 = cvt_pk_bf16(s[2 * c + 1][2], s[2 * c + 1][3]);
        bf16x8 pf; pf[0] = (short)(w0 & 0xffff); pf[1] = (short)(w0 >> 16); pf[2] = (short)(w1 & 0xffff); pf[3] = (short)(w1 >> 16); pf[4] = (short)(w2 & 0xffff); pf[5] = (short)(w2 >> 16); pf[6] = (short)(w3 & 0xffff); pf[7] = (short)(w3 >> 16);
#pragma unroll
        for (int dt = 0; dt < 4; ++dt) { const bf16x8 vf = vl.get(dt, c); o[dt] = __builtin_amdgcn_mfma_f32_16x16x32_bf16(vf, pf, o[dt], 0, 0, 0); }
    }
#pragma unroll
    for (int dt = 0; dt < 4; ++dt) *(u32x2*)(orow + 16 * dt + 4 * g) = pack4(o[dt] * inv);
}

__device__ __forceinline__ float alibi_slope(int h) { return exp2f(-0.5f * (float)(h + 1)); }

__device__ __forceinline__ void attn_prompt_item(LCTX, const Params& P, int layer, int item, unsigned char* lds) {
    unsigned char* ws = uni(P.ws);
    const bf16_t* Z = (const bf16_t*)(ws + WS_Z);
    bf16_t* OATT = (bf16_t*)(ws + WS_OATT);
    const int kvh = item & 3, j = (item >> 2) & 31, b = item >> 7;
    int tid = TIDX; asm volatile("" : "+v"(tid));
    const int lane = tid & 63, wave = tid >> 6, fr = lane & 15, g = lane >> 4;
    unsigned char* ks = lds; unsigned char* vt = lds + 256 * 144;
    const int row0 = b * 4096 + (j - 1) * 128;
    u32x4 kqa[4], vqa[4];
#pragma unroll
    for (int it = 0; it < 4; ++it) { const int p = tid + it * 512, key = p >> 3, d8 = (p & 7) * 8;
        kqa[it] = (u32x4){0u, 0u, 0u, 0u}; vqa[it] = (u32x4){0u, 0u, 0u, 0u};
        if (j > 0 || key >= 128) { const bf16_t* zr = Z + (size_t)(row0 + key) * INC + kvh * 64 + d8; kqa[it] = *(const u32x4*)(zr + C_K); vqa[it] = *(const u32x4*)(zr + C_V); } }
#pragma unroll
    for (int it = 0; it < 4; ++it) { const int p = tid + it * 512, key = p >> 3, d8 = (p & 7) * 8;
        const u32x4 kq = kqa[it], vq = vqa[it];
        *(u32x4*)(ks + key * 144 + d8 * 2) = kq;
        bf16_t* vp = (bf16_t*)(vt + d8 * 528 + (key ^ ((p & 7) << 2)) * 2);
        vp[0 * 264] = (bf16_t)(vq.x & 0xffff); vp[1 * 264] = (bf16_t)(vq.x >> 16); vp[2 * 264] = (bf16_t)(vq.y & 0xffff); vp[3 * 264] = (bf16_t)(vq.y >> 16);
        vp[4 * 264] = (bf16_t)(vq.z & 0xffff); vp[5 * 264] = (bf16_t)(vq.z >> 16); vp[6 * 264] = (bf16_t)(vq.w & 0xffff); vp[7 * 264] = (bf16_t)(vq.w >> 16); }
    __syncthreads();
#pragma unroll 1
    for (int it = 0; it < 4; ++it) {
        const int task = wave + 8 * it, gh = task >> 3, i0 = (task & 7) * 16, h = kvh * 4 + gh;
        const int kbase = i0 < 96 ? i0 : 96;
        const size_t r = (size_t)(b * 4096 + j * 128 + i0 + fr);
        const bf16x8 qf0 = *(const bf16x8*)(Z + r * INC + h * 64 + g * 8), qf1 = *(const bf16x8*)(Z + r * INC + h * 64 + 32 + g * 8);
        const int iq = i0 + fr, dmax = j > 0 ? 128 : iq;
        KLdsLoader kl{ks, fr, g, kbase}; VLdsLoader vl{vt, fr, g, kbase};
        attn_task(kl, vl, qf0, qf1, iq, alibi_slope(h), uni(P.in[I_SINK])[layer * 16 + h], kbase, dmax, OATT + r * DM + h * 64, g);
    }
    __syncthreads();
}

__device__ __forceinline__ void attn_sample_item(LCTX, const Params& P, int layer, int item, unsigned char* lds) {
    unsigned char* ws = uni(P.ws);
    const bf16_t* Z = (const bf16_t*)(ws + WS_Z);
    bf16_t* OATT = (bf16_t*)(ws + WS_OATT);
    const int kvh = item & 3, b = item >> 2;
    int tid = TIDX; asm volatile("" : "+v"(tid));
    const int lane = tid & 63, wave = tid >> 6, fr = lane & 15, g = lane >> 4;
    unsigned char* ks = lds; unsigned char* vt = lds + 256 * 144;
    const size_t cbase = ((size_t)(layer * 128 + b) * 128) * 256 + kvh * 64;
    const float* ck = uni(P.in[I_CK]) + cbase; const float* cv = uni(P.in[I_CV]) + cbase;
    float* wk = uni(P.out) + O_WKS + cbase; float* wv = uni(P.out) + O_WVS + cbase;
    const size_t zrow0 = (size_t)(TP + b * 8);
#pragma unroll 1
    for (int p = tid; p < 160 * 8; p += 512) { const int key = p >> 3, d8 = (p & 7) * 8;
        u32x4 kq = {0u, 0u, 0u, 0u}, vq = {0u, 0u, 0u, 0u};
        if (key < 128) {
            const f32x4 k0 = *(const f32x4*)(ck + (size_t)key * 256 + d8), k1 = *(const f32x4*)(ck + (size_t)key * 256 + d8 + 4);
            const f32x4 v0 = *(const f32x4*)(cv + (size_t)key * 256 + d8), v1 = *(const f32x4*)(cv + (size_t)key * 256 + d8 + 4);
            if (key >= 8) { *(f32x4*)(wk + (size_t)(key - 8) * 256 + d8) = k0; *(f32x4*)(wk + (size_t)(key - 8) * 256 + d8 + 4) = k1;
                            *(f32x4*)(wv + (size_t)(key - 8) * 256 + d8) = v0; *(f32x4*)(wv + (size_t)(key - 8) * 256 + d8 + 4) = v1; }
            kq.x = cvt_pk_bf16(k0[0], k0[1]); kq.y = cvt_pk_bf16(k0[2], k0[3]); kq.z = cvt_pk_bf16(k1[0], k1[1]); kq.w = cvt_pk_bf16(k1[2], k1[3]);
            vq.x = cvt_pk_bf16(v0[0], v0[1]); vq.y = cvt_pk_bf16(v0[2], v0[3]); vq.z = cvt_pk_bf16(v1[0], v1[1]); vq.w = cvt_pk_bf16(v1[2], v1[3]);
        } else if (key < 136) { const bf16_t* zr = Z + (zrow0 + (key - 128)) * INC + kvh * 64 + d8; kq = *(const u32x4*)(zr + C_K); vq = *(const u32x4*)(zr + C_V); }
        *(u32x4*)(ks + key * 144 + d8 * 2) = kq;
        bf16_t* vp = (bf16_t*)(vt + d8 * 528 + (key ^ ((p & 7) << 2)) * 2);
        vp[0 * 264] = (bf16_t)(vq.x & 0xffff); vp[1 * 264] = (bf16_t)(vq.x >> 16); vp[2 * 264] = (bf16_t)(vq.y & 0xffff); vp[3 * 264] = (bf16_t)(vq.y >> 16);
        vp[4 * 264] = (bf16_t)(vq.z & 0xffff); vp[5 * 264] = (bf16_t)(vq.z >> 16); vp[6 * 264] = (bf16_t)(vq.w & 0xffff); vp[7 * 264] = (bf16_t)(vq.w >> 16); }
    __syncthreads();
    if (wave < 2) {
        const int qt = wave, gh = 2 * qt + (fr >> 3), qi = fr & 7, h = kvh * 4 + gh; const size_t r = zrow0 + qi;
        const bf16x8 qf0 = *(const bf16x8*)(Z + r * INC + h * 64 + g * 8), qf1 = *(const bf16x8*)(Z + r * INC + h * 64 + 32 + g * 8);
        KLdsLoader kl{ks, fr, g, 0}; VLdsLoader vl{vt, fr, g, 0};
        attn_task(kl, vl, qf0, qf1, qi, alibi_slope(h), uni(P.in[I_SINK])[layer * 16 + h], 0, 128, OATT + r * DM + h * 64, g);
    }
    __syncthreads();
}

__device__ __forceinline__ void hgrn_sample_item(LCTX, const Params& P, int layer, int item, unsigned char* lds) {
    unsigned char* ws = uni(P.ws);
    const bf16_t* Z = (const bf16_t*)(ws + WS_Z);
    const float* RF = (const float*)(ws + WS_RF);
    float* OREC = (float*)(ws + WS_OREC);
    int tid = TIDX; asm volatile("" : "+v"(tid));
    const int b = item >> 3, h = item & 7, rowbase = TP + b * 8;
    const float* LB = (const float*)(ws + WS_LB) + layer * DM + h * 128;
    const float* s0 = uni(P.in[I_ST]) + ((size_t)((layer * 128 + b) * 8 + h)) * 16384;
    float* sout = uni(P.out) + O_HS + ((size_t)((layer * 128 + b) * 8 + h)) * 16384;
    float* F = (float*)lds; float* KR = F + 1024; float* QR = KR + 1024; float* VV = QR + 1024; float* PO = VV + 1024;
    const int v = tid & 127, kg = tid >> 7, k0 = kg * 32;
    float S[32];
#pragma unroll
    for (int i = 0; i < 32; ++i) S[i] = s0[(size_t)(k0 + i) * 128 + v];
    float rfv[2], lbv[2]; unsigned qv2[2], vv2[2];
#pragma unroll
    for (int e = 0; e < 2; ++e) { const int idx = tid + e * 512, t = idx >> 7, k = idx & 127; const size_t row = (size_t)(rowbase + t);
        rfv[e] = RF[row * DM + h * 128 + k]; lbv[e] = LB[k]; qv2[e] = Z[row * INC + C_RQ + h * 128 + k]; vv2[e] = Z[row * INC + C_RI + h * 128 + k]; }
#pragma unroll
    for (int e = 0; e < 2; ++e) { const int idx = tid + e * 512; const float sg = sigmoidf_(rfv[e]), om = 1.0f - lbv[e];
        F[idx] = lbv[e] + om * sg; KR[idx] = om * (1.0f - sg); QR[idx] = bf2f((bf16_t)qv2[e]); VV[idx] = bf2f((bf16_t)vv2[e]); }
    __syncthreads();
#pragma unroll 1
    for (int t = 0; t < 8; ++t) {
        const float vv = VV[t * 128 + v]; float acc = 0.f;
#pragma unroll
        for (int i4 = 0; i4 < 8; ++i4) {
            const f32x4 f = *(const f32x4*)(F + t * 128 + k0 + 4 * i4), c = *(const f32x4*)(KR + t * 128 + k0 + 4 * i4), q = *(const f32x4*)(QR + t * 128 + k0 + 4 * i4);
#pragma unroll
            for (int j = 0; j < 4; ++j) { S[4 * i4 + j] = f[j] * S[4 * i4 + j] + c[j] * vv; acc += S[4 * i4 + j] * q[j]; }
        }
        PO[(t * 4 + kg) * 128 + v] = acc;
    }
    __syncthreads();
#pragma unroll
    for (int e = 0; e < 2; ++e) { const int idx = tid + e * 512, t = idx >> 7, v2 = idx & 127;
        OREC[(size_t)(rowbase + t) * DM + h * 128 + v2] = (PO[(t * 4 + 0) * 128 + v2] + PO[(t * 4 + 1) * 128 + v2]) + (PO[(t * 4 + 2) * 128 + v2] + PO[(t * 4 + 3) * 128 + v2]); }
#pragma unroll
    for (int i = 0; i < 32; ++i) sout[(size_t)(k0 + i) * 128 + v] = S[i];
    __syncthreads();
}

__device__ __forceinline__ bf16_t f2bf1(float x) { return (bf16_t)(cvt_pk_bf16(x, 0.f) & 0xffffu); }

__device__ __forceinline__ void hg_prep(const GB float* __restrict__ RF, const GB float* __restrict__ LBh, int r0, int h, int k, int seg, float* segt, float (&loc)[16], float (&kr)[16], float (&tot)[4]) {
    const float lb = LBh[k], om = 1.0f - lb;
    float rf[16];
#pragma unroll
    for (int i = 0; i < 16; ++i) rf[i] = RF[(size_t)(r0 + seg * 16 + i) * DM + h * 128 + k];
    float run = 0.f;
#pragma unroll
    for (int i = 0; i < 16; ++i) { const float sg = sigmoidf_(rf[i]); const float f = fmaxf(lb + om * sg, 1e-30f); run += __logf(f); loc[i] = run; kr[i] = om * (1.0f - sg); }
    segt[seg * 128 + k] = run;
    __syncthreads();
#pragma unroll
    for (int s2 = 0; s2 < 4; ++s2) tot[s2] = segt[s2 * 128 + k];
}

__device__ __forceinline__ void hgrn_local_item(LCTX, const Params& P, int layer, int item, unsigned char* lds) {
    unsigned char* ws = uni(P.ws);
    const GB bf16_t* Z = (const GB bf16_t*)(ws + WS_Z);
    int tid = TIDX; asm volatile("" : "+v"(tid));
    const int k = tid & 127, seg = tid >> 7, lane = tid & 63, w = tid >> 6, fr = lane & 15, g = lane >> 4;
    const int b = item >> 9, c = (item >> 3) & 63, h = item & 7, r0 = b * 4096 + c * 64;
    unsigned char* KT = lds; unsigned char* VT = lds + 18432; float* segt = (float*)(lds + 36864);
    unsigned vv[16];
#pragma unroll
    for (int i = 0; i < 16; ++i) vv[i] = Z[(size_t)(r0 + seg * 16 + i) * INC + C_RI + h * 128 + k];
    float loc[16], kr[16], tot[4];
    hg_prep((const GB float*)(ws + WS_RF), (const GB float*)(ws + WS_LB) + layer * DM + h * 128, r0, h, k, seg, segt, loc, kr, tot);
    float after = 0.f;
#pragma unroll
    for (int s2 = 1; s2 < 4; ++s2) if (s2 > seg) after += tot[s2];
    const float endl = after + loc[15];
    {   u32x4 w0, w1; float e[16];
#pragma unroll
        for (int i = 0; i < 16; ++i) e[i] = kr[i] * __expf(endl - loc[i]);
        w0.x = cvt_pk_bf16(e[0], e[1]); w0.y = cvt_pk_bf16(e[2], e[3]); w0.z = cvt_pk_bf16(e[4], e[5]); w0.w = cvt_pk_bf16(e[6], e[7]);
        w1.x = cvt_pk_bf16(e[8], e[9]); w1.y = cvt_pk_bf16(e[10], e[11]); w1.z = cvt_pk_bf16(e[12], e[13]); w1.w = cvt_pk_bf16(e[14], e[15]);
        *(u32x4*)(KT + k * 144 + seg * 32) = w0; *(u32x4*)(KT + k * 144 + seg * 32 + 16) = w1; }
    {   u32x4 w0, w1;
        w0.x = vv[0] | (vv[1] << 16); w0.y = vv[2] | (vv[3] << 16); w0.z = vv[4] | (vv[5] << 16); w0.w = vv[6] | (vv[7] << 16);
        w1.x = vv[8] | (vv[9] << 16); w1.y = vv[10] | (vv[11] << 16); w1.z = vv[12] | (vv[13] << 16); w1.w = vv[14] | (vv[15] << 16);
        *(u32x4*)(VT + k * 144 + seg * 32) = w0; *(u32x4*)(VT + k * 144 + seg * 32 + 16) = w1; }
    if (seg == 0) ((GB float*)(ws + WS_DC))[(size_t)item * 128 + k] = __expf(tot[0] + tot[1] + tot[2] + tot[3]);
    __syncthreads();
    const bf16x8 a0 = *(const bf16x8*)(KT + (16 * w + fr) * 144 + 16 * g), a1 = *(const bf16x8*)(KT + (16 * w + fr) * 144 + 16 * g + 64);
    GB bf16_t* UT = (GB bf16_t*)(ws + WS_UT) + (size_t)item * 16384;
#pragma unroll
    for (int nt = 0; nt < 8; ++nt) {
        const bf16x8 b0 = *(const bf16x8*)(VT + (16 * nt + fr) * 144 + 16 * g), b1 = *(const bf16x8*)(VT + (16 * nt + fr) * 144 + 16 * g + 64);
        f32x4 acc = {0.f, 0.f, 0.f, 0.f};
        acc = __builtin_amdgcn_mfma_f32_16x16x32_bf16(a0, b0, acc, 0, 0, 0);
        acc = __builtin_amdgcn_mfma_f32_16x16x32_bf16(a1, b1, acc, 0, 0, 0);
        *(GB u32x2*)(UT + (16 * nt + fr) * 128 + 16 * w + 4 * g) = pack4(acc);
    }
    __syncthreads();
}

__device__ __forceinline__ void phase_scan(LCTX, const Params& P, int layer, unsigned char* lds) {
    unsigned char* ws = uni(P.ws);
    int tid = TIDX; asm volatile("" : "+v"(tid));
    const GB bf16_t* __restrict__ UT = (const GB bf16_t*)(ws + WS_UT); const GB float* __restrict__ DC = (const GB float*)(ws + WS_DC); GB bf16_t* __restrict__ ST = (GB bf16_t*)(ws + WS_ST);
    float* tile = (float*)lds;
    for (int base = BIDX * 512; base < 32 * 128 * 32; base += GDIM * 512) {
        const int idx = base + tid, p = idx >> 12, v = (idx >> 5) & 127, kq = idx & 31, b = p >> 3, h = p & 7;
        f32x4 S = {0.f, 0.f, 0.f, 0.f};
        size_t item = (size_t)(b * 64) * 8 + h;
#pragma unroll 8
        for (int c = 0; c < 64; ++c, item += 8) {
            *(GB u32x2*)(ST + item * 16384 + v * 128 + 4 * kq) = pack4(S);
            const f32x4 d = *(const GB f32x4*)(DC + item * 128 + 4 * kq); const u32x2 uw = *(const GB u32x2*)(UT + item * 16384 + v * 128 + 4 * kq);
            const f32x4 u = {__uint_as_float(uw.x << 16), __uint_as_float(uw.x & 0xffff0000u), __uint_as_float(uw.y << 16), __uint_as_float(uw.y & 0xffff0000u)};
            S = d * S + u;
        }
        const int vl = (tid >> 5);
        tile[(4 * kq + 0) * 17 + vl] = S[0]; tile[(4 * kq + 1) * 17 + vl] = S[1]; tile[(4 * kq + 2) * 17 + vl] = S[2]; tile[(4 * kq + 3) * 17 + vl] = S[3];
        __syncthreads();
        const int kk = tid >> 2, v4 = (tid & 3) * 4, vb = v - vl;
        f32x4 o; o[0] = tile[kk * 17 + v4]; o[1] = tile[kk * 17 + v4 + 1]; o[2] = tile[kk * 17 + v4 + 2]; o[3] = tile[kk * 17 + v4 + 3];
        *(GB f32x4*)((GB float*)uni(P.out) + O_HP + ((size_t)((layer * 4 + b) * 8 + h)) * 16384 + (size_t)kk * 128 + vb + v4) = o;
        __syncthreads();
    }
}

struct MergeOps { bf16x8 sg[2], sa[2], sr[2], oa[2]; f32x4 hn[4]; };
__device__ __forceinline__ void merge_load(const Params& P, int layer, int row, int c0, MergeOps& m) {
    unsigned char* ws = uni(P.ws);
    const GB bf16_t* zr = (const GB bf16_t*)(ws + WS_Z) + (size_t)row * INC + c0;
    const GB bf16_t* oar = (const GB bf16_t*)(ws + WS_OATT) + (size_t)row * DM + c0;
    const GB float* hn = (const GB float*)uni(P.in[I_HNORM]) + layer * DM + c0;
#pragma unroll
    for (int hf = 0; hf < 2; ++hf) { m.sg[hf] = *(const GB bf16x8*)(zr + C_RG + 8 * hf); m.sa[hf] = *(const GB bf16x8*)(zr + C_GA + 8 * hf); m.sr[hf] = *(const GB bf16x8*)(zr + C_GR + 8 * hf);
        m.oa[hf] = *(const GB bf16x8*)(oar + 8 * hf); }
#pragma unroll
    for (int i = 0; i < 4; ++i) m.hn[i] = *(const GB f32x4*)(hn + 4 * i);
}
__device__ __forceinline__ void merge_store(const Params& P, int row, int c0, const float (&o)[16], float r, const MergeOps& mo) {
    unsigned char* ws = uni(P.ws);
    GB bf16_t* mr = (GB bf16_t*)(ws + WS_MIX) + (size_t)row * DM + c0;
#pragma unroll
    for (int hf = 0; hf < 2; ++hf) {
        float m[8];
#pragma unroll
        for (int i = 0; i < 8; ++i) { const float orec = o[8 * hf + i] * r * mo.hn[2 * hf + (i >> 2)][i & 3] * bf2f((bf16_t)mo.sg[hf][i]);
            m[i] = bf2f((bf16_t)mo.sa[hf][i]) * bf2f((bf16_t)mo.oa[hf][i]) + bf2f((bf16_t)mo.sr[hf][i]) * orec; }
        u32x4 ow; ow.x = cvt_pk_bf16(m[0], m[1]); ow.y = cvt_pk_bf16(m[2], m[3]); ow.z = cvt_pk_bf16(m[4], m[5]); ow.w = cvt_pk_bf16(m[6], m[7]);
        *(GB u32x4*)(mr + 8 * hf) = ow;
    }
}

__device__ __forceinline__ void hgrn_out_item(LCTX, const Params& P, int layer, int item, unsigned char* lds) {
    unsigned char* ws = uni(P.ws);
    const GB bf16_t* Z = (const GB bf16_t*)(ws + WS_Z);
    int tid = TIDX; asm volatile("" : "+v"(tid));
    const int k = tid & 127, seg = tid >> 7, lane = tid & 63, w = tid >> 6, fr = lane & 15, g = lane >> 4;
    const int b = item >> 9, c = (item >> 3) & 63, h = item & 7, r0 = b * 4096 + c * 64;
    unsigned char* QT = lds; unsigned char* ATT = lds + 17408; unsigned char* VT = lds + 26624; unsigned char* QH = lds + 45056; unsigned char* QD = lds + 62464;
    unsigned char* KD = lds + 79872; unsigned char* KH = lds + 97280; float* segt = (float*)(lds + 123392); float* OS = (float*)(lds + 45056);
    unsigned vv[16], qv[16]; bf16x8 bs[4]; MergeOps mo;
    merge_load(P, layer, r0 + (tid >> 3), h * 128 + (tid & 7) * 16, mo);
#pragma unroll
    for (int i = 0; i < 16; ++i) { vv[i] = Z[(size_t)(r0 + seg * 16 + i) * INC + C_RI + h * 128 + k]; qv[i] = Z[(size_t)(r0 + seg * 16 + i) * INC + C_RQ + h * 128 + k]; }
    {   const GB bf16_t* STp = (const GB bf16_t*)(ws + WS_ST) + (size_t)item * 16384 + (16 * w + fr) * 128 + 8 * g;
#pragma unroll
        for (int kk = 0; kk < 4; ++kk) bs[kk] = *(const GB bf16x8*)(STp + 32 * kk); }
    float loc[16], kr[16], tot[4];
    hg_prep((const GB float*)(ws + WS_RF), (const GB float*)(ws + WS_LB) + layer * DM + h * 128, r0, h, k, seg, segt, loc, kr, tot);
    for (int i = tid; i < 2304; i += 512) ((unsigned*)ATT)[i] = 0u;
    {
        u32x4 w0, w1;
        w0.x = vv[0] | (vv[1] << 16); w0.y = vv[2] | (vv[3] << 16); w0.z = vv[4] | (vv[5] << 16); w0.w = vv[6] | (vv[7] << 16);
        w1.x = vv[8] | (vv[9] << 16); w1.y = vv[10] | (vv[11] << 16); w1.z = vv[12] | (vv[13] << 16); w1.w = vv[14] | (vv[15] << 16);
        *(u32x4*)(VT + k * 144 + seg * 32) = w0; *(u32x4*)(VT + k * 144 + seg * 32 + 16) = w1; }
    float offs = 0.f;
#pragma unroll
    for (int s2 = 0; s2 < 3; ++s2) if (s2 < seg) offs += tot[s2];
    const float eoffs = __expf(offs), lmid = loc[7];
#pragma unroll
    for (int i = 0; i < 16; ++i) {
        const int t = seg * 16 + i;
        const float q = bf2f((bf16_t)qv[i]);
        const float qh = q * __expf(loc[i]);
        *(bf16_t*)(QH + t * 272 + 2 * k) = f2bf1(qh);
        *(bf16_t*)(QT + t * 272 + 2 * k) = f2bf1(qh * eoffs);
        *(bf16_t*)(QD + t * 272 + 2 * k) = f2bf1(q * __expf(fminf(loc[i] - lmid, 80.f)));
        *(bf16_t*)(KD + t * 272 + 2 * k) = f2bf1(kr[i] * __expf(fminf(lmid - loc[i], 80.f)));
        float between = tot[seg] - loc[i];
#pragma unroll
        for (int ti = 1; ti < 4; ++ti) { if (ti > seg) { const int kb = 8 * ti * (ti - 1);
                *(bf16_t*)(KH + (kb + t) * 272 + 2 * k) = f2bf1(kr[i] * __expf(between)); between += tot[ti]; } }
    }
    __syncthreads();
    for (int idx = w; idx < 10; idx += 8) {
        const int ti = idx < 1 ? 0 : idx < 3 ? 1 : idx < 6 ? 2 : 3, si = idx - ti * (ti + 1) / 2;
        const bool diag = ti == si;
        const unsigned char* ab = (diag ? QD : QH) + (16 * ti + fr) * 272 + 16 * g;
        const unsigned char* bb = diag ? KD + (16 * ti + fr) * 272 + 16 * g : KH + (8 * ti * (ti - 1) + 16 * si + fr) * 272 + 16 * g;
        f32x4 acc = {0.f, 0.f, 0.f, 0.f};
#pragma unroll
        for (int kk = 0; kk < 4; ++kk) acc = __builtin_amdgcn_mfma_f32_16x16x32_bf16(*(const bf16x8*)(ab + 64 * kk), *(const bf16x8*)(bb + 64 * kk), acc, 0, 0, 0);
#pragma unroll
        for (int r = 0; r < 4; ++r) { float val = acc[r]; if (diag && fr > 4 * g + r) val = 0.f;
            *(bf16_t*)(ATT + (16 * ti + 4 * g + r) * 144 + (16 * si + fr) * 2) = f2bf1(val); }
    }
    __syncthreads();
    {
        bf16x8 bv[2];
#pragma unroll
        for (int kk = 0; kk < 2; ++kk) bv[kk] = *(const bf16x8*)(VT + (16 * w + fr) * 144 + 16 * g + 64 * kk);
#pragma unroll
        for (int mt = 0; mt < 4; ++mt) {
            f32x4 acc = {0.f, 0.f, 0.f, 0.f};
#pragma unroll
            for (int kk = 0; kk < 4; ++kk) acc = __builtin_amdgcn_mfma_f32_16x16x32_bf16(*(const bf16x8*)(QT + (16 * mt + fr) * 272 + 16 * g + 64 * kk), bs[kk], acc, 0, 0, 0);
#pragma unroll
            for (int kk = 0; kk < 2; ++kk) acc = __builtin_amdgcn_mfma_f32_16x16x32_bf16(*(const bf16x8*)(ATT + (16 * mt + fr) * 144 + 16 * g + 64 * kk), bv[kk], acc, 0, 0, 0);
#pragma unroll
            for (int r = 0; r < 4; ++r) OS[(16 * mt + 4 * g + r) * 132 + 16 * w + fr] = acc[r];
        }
    }
    __syncthreads();
    {   const int t = tid >> 3, vs = (tid & 7) * 16;
        float o[16]; float ss = 0.f;
#pragma unroll
        for (int i = 0; i < 4; ++i) { const f32x4 v = *(const f32x4*)(OS + t * 132 + vs + 4 * i); o[4 * i] = v[0]; o[4 * i + 1] = v[1]; o[4 * i + 2] = v[2]; o[4 * i + 3] = v[3];
            ss += v[0] * v[0] + v[1] * v[1] + v[2] * v[2] + v[3] * v[3]; }
        ss += __shfl_xor(ss, 1); ss += __shfl_xor(ss, 2); ss += __shfl_xor(ss, 4);
        merge_store(P, r0 + t, h * 128 + vs, o, rsqrtf(ss * (1.0f / 128.0f) + EPS), mo);
    }
    __syncthreads();
}

__device__ __forceinline__ void phase_mix(LCTX, const Params& P, int layer, unsigned char* lds) {
    int first = BIDX, stride = GDIM;
    if (EN2 & 4) for (int item = first; item < 2048; item += stride) hgrn_local_item(LARG, P, layer, item, lds);
    asm volatile("" : "+s"(first)); asm volatile("" : "+s"(stride));
    if (EN2 & 1) for (int item = first; item < 512; item += stride) attn_prompt_item(LARG, P, layer, item, lds);
    asm volatile("" : "+s"(first)); asm volatile("" : "+s"(stride));
    if (EN2 & 2) for (int item = first; item < 512; item += stride) attn_sample_item(LARG, P, layer, item, lds);
    asm volatile("" : "+s"(first)); asm volatile("" : "+s"(stride));
    if (EN2 & 8) for (int item = first; item < 1024; item += stride) hgrn_sample_item(LARG, P, layer, item, lds);
}

__device__ __forceinline__ void phase_hout(LCTX, const Params& P, int layer, unsigned char* lds) {
    int first = BIDX, stride = GDIM;
    for (int item = first; item < 2048; item += stride) hgrn_out_item(LARG, P, layer, item, lds);
    asm volatile("" : "+s"(first)); asm volatile("" : "+s"(stride));
    int tid = TIDX; asm volatile("" : "+v"(tid));
    const GB float* OREC = (const GB float*)(uni(P.ws) + WS_OREC);
    const int lane = tid & 63, wave = tid >> 6, c0 = lane * 16;
    for (int row = TP + first * 8 + wave; row < TT; row += stride * 8) {
        float o[16]; float ss = 0.f;
#pragma unroll
        for (int i = 0; i < 4; ++i) { const f32x4 v = *(const GB f32x4*)(OREC + (size_t)row * DM + c0 + 4 * i); o[4 * i] = v[0]; o[4 * i + 1] = v[1]; o[4 * i + 2] = v[2]; o[4 * i + 3] = v[3];
            ss += v[0] * v[0] + v[1] * v[1] + v[2] * v[2] + v[3] * v[3]; }
        ss += __shfl_xor(ss, 1); ss += __shfl_xor(ss, 2); ss += __shfl_xor(ss, 4);
        MergeOps mo; merge_load(P, layer, row, c0, mo);
        merge_store(P, row, c0, o, rsqrtf(ss * (1.0f / 128.0f) + EPS), mo);
    }
}

#ifndef EN2
#define EN2 31
#endif
#ifndef EN
#define EN 511
#endif
#ifndef DUPLO
#define DUPLO 9
#define DUPHI 8
#endif
constexpr int NDUP = (DUPHI >= DUPLO) ? (DUPHI - DUPLO + 1) : 0;
constexpr int NSUB = 9 + NDUP;
constexpr int N_PHASES = 2 + NSUB * NLAYER + 1;

__global__ void __launch_bounds__(NTHREADS, 2) fwd_kernel(Params Parg) {
    extern __shared__ __attribute__((aligned(16))) unsigned char lds[];
    cg::grid_group grid = cg::this_grid();
    const Params* pp0 = (const Params*)__builtin_amdgcn_kernarg_segment_ptr();
    const int ph_lo = Parg.ph_lo, ph_hi = Parg.ph_hi;
    const int wave_s = __builtin_amdgcn_readfirstlane(threadIdx.x >> 6);
    LAS unsigned char* ldsl = (LAS unsigned char*)lds;
    for (int ph = ph_lo; ph < ph_hi; ++ph) {
        const Params* pp = pp0; asm volatile("" : "+s"(pp));
        const Params& P = *pp;
#define ws (uni(P.ws))
        int wv_l = wave_s, bid_l = blockIdx.x, G_l = gridDim.x; asm volatile("" : "+s"(wv_l)); asm volatile("" : "+s"(bid_l)); asm volatile("" : "+s"(G_l));
        const int G = G_l, bid = bid_l;
        if (ph == 0) { if (EN & 1) phase_prologue(LARG, P, lds); }
        else if (ph == 1) {
            pg8::Gemm g{(const bf16_t*)(ws + WS_AC), (const bf16_t*)(ws + WS_WADA), 256, MODLD, DM, DM}; pg8::StaticOrder S; S.init(256, MODLD, G, bid);
            EpiAda E{(GB float*)(ws + WS_MOD), (const GB float*)uni(P.in[I_BADA])};
            if (EN & 2) pg8::gemm_phase<EpiAda, pg8::StaticOrder, true, true>(ldsl, g, S, E, fresh_tid(wv_l));
        } else if (ph == N_PHASES - 1) { if (EN & 4) phase_norm(LARG, P, 0, 2); }
        else {
            const int layer = (ph - 2) / NSUB, si_ = (ph - 2) % NSUB;
            const int sub = (NDUP == 0 || si_ < DUPLO) ? si_ : (si_ < DUPLO + 2 * NDUP ? DUPLO + ((si_ - DUPLO) >> 1) : si_ - NDUP);
            if (sub == 0) { if (EN & 4) phase_norm(LARG, P, layer, 0); }
            else if (sub == 1) {
                pg8::Gemm g{(const bf16_t*)(ws + WS_H), (const bf16_t*)(ws + WS_WIN) + (size_t)layer * INC * DM, TT, INC, DM, DM}; pg8::StaticOrder S; S.init(TT, INC, G, bid);
                EpiIn E{(GB bf16_t*)(ws + WS_Z), (GB float*)(ws + WS_RF), (GB float*)uni(P.out), layer};
                if (EN & 8) pg8::gemm_phase<EpiIn, pg8::StaticOrder, true, true>(ldsl, g, S, E, fresh_tid(wv_l));
            } else if (sub == 2) { if (EN & 16) phase_mix(LARG, P, layer, lds); }
            else if (sub == 3) { if (EN & 32) phase_scan(LARG, P, layer, lds); }
            else if (sub == 4) { if (EN & 32) phase_hout(LARG, P, layer, lds); }
            else if (sub == 5 || sub == 8) {
                const bool dn = sub == 8;
                const float* mod = (const float*)(ws + WS_MOD); float* X = (float*)(ws + WS_X);
                const bf16_t* Ap = dn ? (const bf16_t*)(ws + WS_Z) : (const bf16_t*)(ws + WS_MIX);
                const bf16_t* Bp = dn ? (const bf16_t*)(ws + WS_WDN) + (size_t)layer * DM * DFF : (const bf16_t*)(ws + WS_WOUT) + (size_t)layer * DM * DM;
                const int Kf = dn ? DFF : DM;
                const float* gate = mod + layer * NMOD + (dn ? 5 : 2) * DM;
                {
                    pg8::Gemm g{Ap, Bp, TP, DM, Kf, Kf}; pg8::StaticOrder S; S.init(TP, DM, G, bid);
                    EpiRes E{(const GB float*)((layer == 0 && !dn) ? uni(P.in[I_XP]) : X), (const GB float*)(X + (size_t)TP * DM), (GB float*)X, (const GB float*)gate};
                    if (EN & 64) pg8::gemm_phase<EpiRes, pg8::StaticOrder, true, true>(ldsl, g, S, E, fresh_tid(wv_l));
                }
                {
                    pg8::Gemm g{Ap, Bp, TT, DM, dn ? 1024 : 512, Kf}; SampleSplitOrder S{dn ? 4 : 2, G, bid};
                    EpiPart E{(GB float*)(ws + WS_PART)};
                    if (EN & 64) pg8::gemm_phase<EpiPart, SampleSplitOrder, true, true>(ldsl, g, S, E, fresh_tid(wv_l));
                }
            } else if (sub == 6) { if (EN & 4) phase_norm(LARG, P, layer, 1); }
            else if (sub == 7) {
                pg8::Gemm g{(const bf16_t*)(ws + WS_H), (const bf16_t*)(ws + WS_WUP) + (size_t)layer * DFF * DM, TT, DFF, DM, DM}; pg8::StaticOrder S; S.init(TT, DFF, G, bid);
                EpiUp E{(GB bf16_t*)(ws + WS_Z)};
                if (EN & 128) pg8::gemm_phase<EpiUp, pg8::StaticOrder, true, true>(ldsl, g, S, E, fresh_tid(wv_l));
            }
        }
        if (ph + 1 < ph_hi) { asm volatile("s_waitcnt vmcnt(0) lgkmcnt(0)" ::: "memory"); __syncthreads(); grid.sync(); }
    }
}

#ifndef MULTI_LAUNCH
#define MULTI_LAUNCH 0
#endif

#undef ws
extern "C" void kernel_launch(void* const* d_in, const int* in_sizes, int n_in, void* d_out, int out_size, void* d_ws, size_t ws_size, hipStream_t stream) {
    static int grid_blocks = 0;
    if (grid_blocks == 0) {
        if (n_in != 19 || ws_size < WS_END) { fprintf(stderr, "kernel_launch: need 19 inputs and %zu bytes of workspace; got %d, %zu\n", (size_t)WS_END, n_in, ws_size); grid_blocks = -1; return; }
        int dev = 0, cus = 0, per_cu = 0;
        hipGetDevice(&dev);
        hipDeviceGetAttribute(&cus, hipDeviceAttributeMultiprocessorCount, dev);
        if (hipFuncSetAttribute((const void*)fwd_kernel, hipFuncAttributeMaxDynamicSharedMemorySize, LDS_BYTES) != hipSuccess) { fprintf(stderr, "kernel_launch: hipFuncSetAttribute failed\n"); grid_blocks = -1; return; }
        hipOccupancyMaxActiveBlocksPerMultiprocessor(&per_cu, (const void*)fwd_kernel, NTHREADS, LDS_BYTES);
        if (per_cu < 1) { fprintf(stderr, "kernel_launch: occupancy query says %d blocks per CU\n", per_cu); per_cu = 1; }
        (void)hipGetLastError();
        grid_blocks = cus * 1;
        fprintf(stderr, "kernel_launch: cus %d per_cu %d grid %d\n", cus, per_cu, grid_blocks);
    }
    if (grid_blocks < 0) return;
    Params p{};
    for (int i = 0; i < 19; ++i) p.in[i] = (const float*)d_in[i];
    p.out = (float*)d_out; p.ws = (unsigned char*)d_ws;
#if MULTI_LAUNCH
    for (int ph = 0; ph < N_PHASES; ++ph) { p.ph_lo = ph; p.ph_hi = ph + 1;
        hipLaunchKernelGGL(fwd_kernel, dim3(grid_blocks), dim3(NTHREADS), LDS_BYTES, stream, p); }
#else
    p.ph_lo = 0; p.ph_hi = N_PHASES;
    void* args[] = {&p};
    hipError_t e = hipLaunchCooperativeKernel((const void*)fwd_kernel, dim3(grid_blocks), dim3(NTHREADS), args, LDS_BYTES, stream);
    if (e != hipSuccess) fprintf(stderr, "cooperative launch failed: %s (grid %d)\n", hipGetErrorString(e), grid_blocks);
#endif
}
```
